# Optimizing an MI355X kernel written in HIP

```python
import math
import jax, jax.numpy as jnp
from jax import lax
import numpy as np

D_MODEL = 1024
BATCH = 8
SEQ = 2048
DEPTH = 4

CTX_LEN = 256
GRID_W = 64

MLA_HEADS = 4
QK_NOPE = 64
QK_ROPE = 32
V_DIM = 64
Q_LORA = 256
KV_LORA = 128
ATTN_W = MLA_HEADS * V_DIM
Q_BLOCK = 128
ROPE_BASE = 10000.0
AXIS_DIM = QK_ROPE // 2
AXIS_FREQS = AXIS_DIM // 2

CONV_W = 256
CONV_K = 31

FOURIER_W = 256
FOURIER_GROUPS = 4
FOURIER_GDIM = FOURIER_W // FOURIER_GROUPS

SGU_W = 256
SGU_GROUPS = 4
SGU_GDIM = SGU_W // SGU_GROUPS
CHUNK = 128

MIX_W = ATTN_W + CONV_W + FOURIER_W + SGU_W

Q_OFF = 0
KV_OFF = Q_OFF + Q_LORA
ROPE_OFF = KV_OFF + KV_LORA
CONV_OFF = ROPE_OFF + QK_ROPE
FOUR_OFF = CONV_OFF + 2 * CONV_W
SGU_OFF = FOUR_OFF + FOURIER_W
GATE_OFF = SGU_OFF + 2 * SGU_W
IN_DIM = GATE_OFF + MIX_W

RMS_EPS = 1e-6
LN_EPS = 1e-5

kernel_name = "hymba_style_mla_conformer_fnet_gmlp_dit"


def _rmsnorm(x, g):
    xf = x.astype(jnp.float32)
    y = xf * lax.rsqrt(jnp.mean(xf * xf, axis=-1, keepdims=True) + RMS_EPS)
    return (y * g.astype(jnp.float32)).astype(x.dtype)


def _layernorm(x, g, b):
    xf = x.astype(jnp.float32)
    mu = jnp.mean(xf, axis=-1, keepdims=True)
    var = jnp.mean(jnp.square(xf - mu), axis=-1, keepdims=True)
    y = (xf - mu) * lax.rsqrt(var + LN_EPS)
    return (y * g.astype(jnp.float32) + b.astype(jnp.float32)).astype(x.dtype)


def _axial_tables(n_tokens):
    rows = n_tokens // GRID_W
    row = jnp.broadcast_to(jnp.arange(rows)[:, None], (rows, GRID_W)).reshape(-1).astype(jnp.float32)
    col = jnp.broadcast_to(jnp.arange(GRID_W)[None, :], (rows, GRID_W)).reshape(-1).astype(jnp.float32)
    inv = ROPE_BASE ** (-jnp.arange(0, AXIS_DIM, 2, dtype=jnp.float32) / AXIS_DIM)
    ang = jnp.stack([row[:, None] * inv, col[:, None] * inv], axis=1)
    return jnp.cos(ang), jnp.sin(ang)


def _rope2d(x, cos, sin):
    shp = (1, cos.shape[0]) + (1,) * (x.ndim - 3) + (2, AXIS_FREQS)
    c = cos.reshape(shp)
    s = sin.reshape(shp)
    xr = x.astype(jnp.float32).reshape(x.shape[:-1] + (2, 2, AXIS_FREQS))
    x1, x2 = xr[..., 0, :], xr[..., 1, :]
    out = jnp.stack([x1 * c - x2 * s, x1 * s + x2 * c], axis=-2)
    return out.reshape(x.shape).astype(x.dtype)


def _mla_q(q_part, p):
    b, n, _ = q_part.shape
    c_q = _rmsnorm(q_part, p["q_norm_g"])
    return (c_q @ p["w_uq"]).reshape(b, n, MLA_HEADS, QK_NOPE + QK_ROPE)


def _mla_kv(kv_part, p):
    b, n, _ = kv_part.shape
    c_kv = _rmsnorm(kv_part[..., :KV_LORA], p["kv_norm_g"])
    kv = (c_kv @ p["w_ukv"]).reshape(b, n, MLA_HEADS, QK_NOPE + V_DIM)
    return kv[..., :QK_NOPE], kv_part[..., KV_LORA:], kv[..., QK_NOPE:]


def _assemble_k(k_nope, k_rope):
    k_r = jnp.broadcast_to(k_rope[:, :, None, :], k_nope.shape[:3] + (QK_ROPE,))
    return jnp.concatenate([k_nope, k_r], axis=-1)


def _attend(q, k, v):
    scale = 1.0 / math.sqrt(QK_NOPE + QK_ROPE)
    s = jnp.einsum("bqhd,bkhd->bhqk", q, k, preferred_element_type=jnp.float32) * scale
    pr = jax.nn.softmax(s, axis=-1)
    return jnp.einsum("bhqk,bkhd->bqhd", pr.astype(v.dtype), v)


def _block_attention(q, k, v):
    b, n, h, dk = q.shape
    nb = n // Q_BLOCK
    qb = q.reshape(b, nb, Q_BLOCK, h, dk).swapaxes(0, 1)
    ob = lax.map(lambda qq: _attend(qq, k, v), qb)
    return ob.swapaxes(0, 1).reshape(b, n, h * V_DIM)


def _conv_module(a, p):
    glu = a[..., :CONV_W] * jax.nn.sigmoid(a[..., CONV_W:])
    y = lax.conv_general_dilated(
        glu, p["conv_w"][:, None, :].astype(glu.dtype), window_strides=(1,),
        padding=[(CONV_K // 2, CONV_K // 2)], dimension_numbers=("NWC", "WIO", "NWC"),
        feature_group_count=CONV_W)
    y = y + p["conv_b"]
    y = jax.nn.silu(_layernorm(y, p["conv_ln_g"], p["conv_ln_b"]))
    return y @ p["w_pw"] + p["b_pw"]


def _fourier(f, p):
    b, n, _ = f.shape
    fg = f.astype(jnp.float32).reshape(b, n, FOURIER_GROUPS, FOURIER_GDIM)
    mixed = jnp.fft.fft2(fg, axes=(1, 3), norm="ortho").real.reshape(b, n, FOURIER_W).astype(f.dtype)
    return mixed @ p["w_fourier"] + p["b_fourier"]


def _spatial_gating(uv, p):
    u, v = uv[..., :SGU_W], uv[..., SGU_W:]
    v = _layernorm(v, p["sgu_ln_g"], p["sgu_ln_b"])
    b, n, _ = v.shape
    vc = v.reshape(b, n // CHUNK, CHUNK, SGU_GROUPS, SGU_GDIM)
    mixed = jnp.einsum("gij,bnjgc->bnigc", p["w_s"], vc) + p["b_s"].T[None, None, :, :, None]
    return u * mixed.reshape(b, n, SGU_W)


def _branches(hp, attn, p):
    conv = _conv_module(hp[..., CONV_OFF:FOUR_OFF], p)
    four = _fourier(hp[..., FOUR_OFF:SGU_OFF], p)
    sgu = _spatial_gating(hp[..., SGU_OFF:GATE_OFF], p)
    y = jnp.concatenate([attn, conv, four, sgu], axis=-1) * jax.nn.silu(hp[..., GATE_OFF:])
    return y @ p["w_out"]


def _layer(x, xc, c, c_ctx, p, cos, sin, need_ctx_out):
    shift, scale, gate = jnp.split(jax.nn.silu(c) @ p["w_ada"] + p["b_ada"], 3, axis=-1)
    shift_c, scale_c, gate_c = jnp.split(jax.nn.silu(c_ctx) @ p["w_ada"] + p["b_ada"], 3, axis=-1)
    h = _rmsnorm(x, p["norm_g"]) * (1.0 + scale[:, None, :]) + shift[:, None, :]
    hc = _rmsnorm(xc, p["norm_g"]) * (1.0 + scale_c) + shift_c

    hp = h @ p["w_in"]
    if need_ctx_out:
        hpc = hc @ p["w_in"]
        ctx_kv = hpc[..., KV_OFF:CONV_OFF]
    else:
        ctx_kv = hc @ p["w_in"][:, KV_OFF:CONV_OFF]

    kn_c, kr_c, v_c = _mla_kv(ctx_kv, p)
    k_c = _assemble_k(kn_c, kr_c)

    q = _mla_q(hp[..., Q_OFF:KV_OFF], p)
    q = jnp.concatenate([q[..., :QK_NOPE], _rope2d(q[..., QK_NOPE:], cos, sin)], axis=-1)
    kn, kr, v = _mla_kv(hp[..., KV_OFF:CONV_OFF], p)
    k = _assemble_k(kn, _rope2d(kr, cos, sin))
    k_all = jnp.concatenate([k, k_c], axis=1)
    v_all = jnp.concatenate([v, v_c], axis=1)
    attn = _block_attention(q, k_all, v_all)

    x = x + gate[:, None, :] * _branches(hp, attn, p)

    if need_ctx_out:
        q_c = _mla_q(hpc[..., Q_OFF:KV_OFF], p)
        b, l = xc.shape[0], xc.shape[1]
        attn_c = _attend(q_c, k_c, v_c).reshape(b, l, ATTN_W)
        xc = xc + gate_c * _branches(hpc, attn_c, p)
    return x, xc


def setup_inputs(seed: int = 0) -> dict:
    key = jax.random.key(seed)
    ks = iter(jax.random.split(key, 40))
    f32 = jnp.float32

    def nrm(shape, s):
        return jax.random.normal(next(ks), shape, f32) * s

    def gain(shape):
        return 1.0 + 0.02 * jax.random.normal(next(ks), shape, f32)

    L = DEPTH
    return {
        "x": nrm((BATCH, SEQ, D_MODEL), 1.0),
        "c": nrm((BATCH, D_MODEL), 1.0),
        "ctx": nrm((BATCH, CTX_LEN, D_MODEL), 1.0),
        "c_ctx": nrm((D_MODEL,), 1.0),
        "w_ada": nrm((L, D_MODEL, 3 * D_MODEL), 0.5 * D_MODEL ** -0.5),
        "b_ada": nrm((L, 3 * D_MODEL), 0.01),
        "norm_g": gain((L, D_MODEL)),
        "w_in": nrm((L, D_MODEL, IN_DIM), D_MODEL ** -0.5),
        "q_norm_g": gain((L, Q_LORA)),
        "w_uq": nrm((L, Q_LORA, MLA_HEADS * (QK_NOPE + QK_ROPE)), Q_LORA ** -0.5),
        "kv_norm_g": gain((L, KV_LORA)),
        "w_ukv": nrm((L, KV_LORA, MLA_HEADS * (QK_NOPE + V_DIM)), KV_LORA ** -0.5),
        "conv_w": nrm((L, CONV_K, CONV_W), CONV_K ** -0.5),
        "conv_b": nrm((L, CONV_W), 0.01),
        "conv_ln_g": gain((L, CONV_W)),
        "conv_ln_b": nrm((L, CONV_W), 0.01),
        "w_pw": nrm((L, CONV_W, CONV_W), CONV_W ** -0.5),
        "b_pw": nrm((L, CONV_W), 0.01),
        "w_fourier": nrm((L, FOURIER_W, FOURIER_W), FOURIER_W ** -0.5),
        "b_fourier": nrm((L, FOURIER_W), 0.01),
        "sgu_ln_g": gain((L, SGU_W)),
        "sgu_ln_b": nrm((L, SGU_W), 0.01),
        "w_s": nrm((L, SGU_GROUPS, CHUNK, CHUNK), 0.5 * CHUNK ** -0.5),
        "b_s": 1.0 + nrm((L, SGU_GROUPS, CHUNK), 0.1),
        "w_out": nrm((L, MIX_W, D_MODEL), MIX_W ** -0.5),
        "final_g": gain((D_MODEL,)),
    }


def reference(x, c, ctx, c_ctx, w_ada, b_ada, norm_g, w_in, q_norm_g, w_uq, kv_norm_g, w_ukv,
              conv_w, conv_b, conv_ln_g, conv_ln_b, w_pw, b_pw, w_fourier, b_fourier,
              sgu_ln_g, sgu_ln_b, w_s, b_s, w_out, final_g):
    n_tokens = x.shape[1]
    cos, sin = _axial_tables(n_tokens)
    xc = ctx
    for i in range(DEPTH):
        p = {
            "w_ada": w_ada[i], "b_ada": b_ada[i], "norm_g": norm_g[i], "w_in": w_in[i],
            "q_norm_g": q_norm_g[i], "w_uq": w_uq[i], "kv_norm_g": kv_norm_g[i], "w_ukv": w_ukv[i],
            "conv_w": conv_w[i], "conv_b": conv_b[i], "conv_ln_g": conv_ln_g[i], "conv_ln_b": conv_ln_b[i],
            "w_pw": w_pw[i], "b_pw": b_pw[i], "w_fourier": w_fourier[i], "b_fourier": b_fourier[i],
            "sgu_ln_g": sgu_ln_g[i], "sgu_ln_b": sgu_ln_b[i], "w_s": w_s[i], "b_s": b_s[i],
            "w_out": w_out[i],
        }
        x, xc = _layer(x, xc, c, c_ctx, p, cos, sin, need_ctx_out=(i < DEPTH - 1))
    return _rmsnorm(x, final_g)
```

```cpp
#include <hip/hip_runtime.h>
#include <hip/hip_cooperative_groups.h>
#include <cstdio>
namespace cg = cooperative_groups;

typedef unsigned short bf16_t;
using bf16x8 = __attribute__((ext_vector_type(8))) short;
using f32x4 = __attribute__((ext_vector_type(4))) float;
using u32x4 = __attribute__((ext_vector_type(4))) unsigned int;

#ifndef MK_COOP
#define MK_COOP 1
#endif

constexpr int NROW = 18432;
constexpr int NLAT = 16384;
constexpr int HPS = 2560;
constexpr int HQ = 0, HKV = 256, HCONV = 384, HSGU = 896, HGATE = 1408, HROPE = 2432;
constexpr int NIN = 2816;
constexpr int LSTR = 80;
constexpr int KSTR = 112;

struct Params {
  const float *x, *c, *ctx, *c_ctx, *w_ada, *b_ada, *norm_g, *w_in, *q_norm_g, *w_uq, *kv_norm_g, *w_ukv,
      *conv_w, *conv_b, *conv_ln_g, *conv_ln_b, *w_pw, *b_pw, *w_fourier, *b_fourier,
      *sgu_ln_g, *sgu_ln_b, *w_s, *b_s, *w_out, *final_g;
  float* out;
  float *xc, *mod, *rstdq, *rstdkv;
  bf16_t *h, *convA, *vnT, *T;
  bf16_t *y, *hp, *XT, *XTc, *q, *qc, *kall, *vT;
  bf16_t *WinT, *WoutT, *WuqT, *WukvT, *WpwT, *WfT, *Wsb, *CS2048, *CS256;
  unsigned* bar;
};

typedef const __attribute__((address_space(4))) Params* KP;
__device__ __forceinline__ KP kparams() {
  KP pp = (KP)__builtin_amdgcn_kernarg_segment_ptr();
  asm volatile("" : "+s"(pp));
  return pp;
}

__device__ __forceinline__ int tid_opaque() {
  int t = threadIdx.x;
  asm volatile("" : "+v"(t));
  return t;
}
__device__ __forceinline__ bf16_t f2bf(float f) {
  unsigned u = __float_as_uint(f);
  u += 0x7fffu + ((u >> 16) & 1u);
  return (bf16_t)(u >> 16);
}
__device__ __forceinline__ float bf2f(bf16_t h) { return __uint_as_float(((unsigned)h) << 16); }
typedef __bf16 bf16x2_t __attribute__((ext_vector_type(2)));
typedef float f32x2_t __attribute__((ext_vector_type(2)));
__device__ __forceinline__ unsigned pack2(float a, float b) {
  const f32x2_t v = {a, b};
  return __builtin_bit_cast(unsigned, __builtin_convertvector(v, bf16x2_t));
}
__device__ __forceinline__ float sigmoid_f(float x) { return __builtin_amdgcn_rcpf(1.f + __builtin_amdgcn_exp2f(-1.4426950408889634f * x)); }
__device__ __forceinline__ float silu_f(float x) { return x * sigmoid_f(x); }
__device__ __forceinline__ float quad16_max(float v) {
  auto r = __builtin_amdgcn_permlane16_swap(__float_as_uint(v), __float_as_uint(v), false, false);
  const float m = fmaxf(__uint_as_float(r[0]), __uint_as_float(r[1]));
  auto r2 = __builtin_amdgcn_permlane32_swap(__float_as_uint(m), __float_as_uint(m), false, false);
  return fmaxf(__uint_as_float(r2[0]), __uint_as_float(r2[1]));
}
__device__ __forceinline__ float quad16_sum(float v) {
  auto r = __builtin_amdgcn_permlane16_swap(__float_as_uint(v), __float_as_uint(v), false, false);
  const float m = __uint_as_float(r[0]) + __uint_as_float(r[1]);
  auto r2 = __builtin_amdgcn_permlane32_swap(__float_as_uint(m), __float_as_uint(m), false, false);
  return __uint_as_float(r2[0]) + __uint_as_float(r2[1]);
}
template <int CTRL>
__device__ __forceinline__ float dpp_mov(float v) {
  return __uint_as_float((unsigned)__builtin_amdgcn_update_dpp(0, (int)__float_as_uint(v), CTRL, 0xf, 0xf, true));
}
__device__ __forceinline__ float wave_sum(float v) {
  v += dpp_mov<0xB1>(v);
  v += dpp_mov<0x4E>(v);
  v += dpp_mov<0x124>(v);
  v += dpp_mov<0x128>(v);
  return quad16_sum(v);
}
__device__ __forceinline__ const float* xsrc_row(KP p, int l, int row) {
  if (row < NLAT) return (l == 0 ? p->x : (const float*)p->out) + (size_t)row * 1024;
  return (l == 0 ? p->ctx : (const float*)p->xc) + (size_t)(row - NLAT) * 1024;
}
__device__ __forceinline__ float* xdst_row(KP p, int row) {
  return row < NLAT ? p->out + (size_t)row * 1024 : p->xc + (size_t)(row - NLAT) * 1024;
}
__device__ __forceinline__ float rope_inv(int f) {
  const float t[8] = {1.f, 0.316227766f, 0.1f, 0.0316227766f, 0.01f, 0.00316227766f, 0.001f, 0.000316227766f};
  float r = t[0];
#pragma unroll
  for (int i = 1; i < 8; ++i) r = (f == i) ? t[i] : r;
  return r;
}

struct EpiIn {
  bf16_t *hp, *XT, *XTc;
  __device__ __forceinline__ void operator()(int row0, int col, f32x4 v) const {
    if (col < HPS) {
#pragma unroll
      for (int r = 0; r < 4; ++r) hp[(size_t)(row0 + r) * HPS + col] = f2bf(v[r]);
    } else {
      const int ch = col - HPS;
      bf16_t* dst;
      if (row0 < NLAT) { const int b = row0 >> 11, s = row0 & 2047; dst = XT + ((size_t)(b * 256 + ch) * 2048 + s); }
      else { const int rr = row0 - NLAT; const int b = rr >> 8, t = rr & 255; dst = XTc + ((size_t)(b * 256 + ch) * 256 + t); }
      uint2 u; u.x = pack2(v[0], v[1]); u.y = pack2(v[2], v[3]);
      *(uint2*)dst = u;
    }
  }
};
struct EpiQ {
  bf16_t *q, *qc; const float* rstd;
  __device__ __forceinline__ void operator()(int row0, int col, f32x4 v) const {
    const int h = col / 96, d = col - h * 96;
#pragma unroll
    for (int r = 0; r < 4; ++r) {
      const int row = row0 + r;
      const float val = v[r] * rstd[row];
      if (row < NLAT) { const int b = row >> 11, s = row & 2047; q[((size_t)(b * 4 + h) * 2048 + s) * 96 + d] = f2bf(val); }
      else { const int rr = row - NLAT; const int b = rr >> 8, t = rr & 255; qc[((size_t)(b * 4 + h) * 256 + t) * 96 + d] = f2bf(val); }
    }
  }
};
struct EpiKV {
  bf16_t *kall, *vT; const float* rstd;
  __device__ __forceinline__ void operator()(int row0, int col, f32x4 v) const {
    const int h = col >> 7, part = (col >> 6) & 1, d = col & 63;
    int b, pos;
    if (row0 < NLAT) { b = row0 >> 11; pos = row0 & 2047; } else { const int rr = row0 - NLAT; b = rr >> 8; pos = 2048 + (rr & 255); }
    float w[4];
#pragma unroll
    for (int r = 0; r < 4; ++r) w[r] = v[r] * rstd[row0 + r];
    if (part == 0) {
#pragma unroll
      for (int r = 0; r < 4; ++r) kall[((size_t)(b * 4 + h) * 2304 + pos + r) * 96 + d] = f2bf(w[r]);
    } else {
      uint2 u; u.x = pack2(w[0], w[1]); u.y = pack2(w[2], w[3]);
      *(uint2*)(vT + ((size_t)(b * 4 + h) * 64 + d) * 2304 + pos) = u;
    }
  }
};
struct EpiDFT {
  bf16_t* T; int rowbase, mask, shift, mirror;
  __device__ __forceinline__ void operator()(int row0, int col, f32x4 v) const {
    const int tok = col & mask, half = col >> shift;
    uint2 u; u.x = pack2(v[0], v[1]); u.y = pack2(v[2], v[3]);
    *(uint2*)(T + (size_t)(rowbase + tok) * 512 + half * 256 + row0) = u;
    if (mirror && tok > 0) {
      uint2 w;
      if (half) { w.x = pack2(-v[0], -v[1]); w.y = pack2(-v[2], -v[3]); } else w = u;
      *(uint2*)(T + (size_t)(rowbase + 2048 - tok) * 512 + half * 256 + row0) = w;
    }
  }
};
struct EpiGated {
  bf16_t* y; const bf16_t* hp; const float* bias; int gcol0, ycol0;
  __device__ __forceinline__ void operator()(int row0, int col, f32x4 v) const {
    const float bb = bias[col];
#pragma unroll
    for (int r = 0; r < 4; ++r) {
      const int row = row0 + r;
      const float g = bf2f(hp[(size_t)row * HPS + gcol0 + col]);
      y[(size_t)row * 1024 + ycol0 + col] = f2bf((v[r] + bb) * silu_f(g));
    }
  }
};
struct EpiSGU {
  bf16_t* y; const bf16_t* hp; const float* bs; int rowbase, g;
  __device__ __forceinline__ void operator()(int row0, int col, f32x4 v) const {
#pragma unroll
    for (int r = 0; r < 4; ++r) {
      const int i = row0 + r, row = rowbase + i;
      const float u = bf2f(hp[(size_t)row * HPS + HSGU + g * 64 + col]);
      const float gt = bf2f(hp[(size_t)row * HPS + HGATE + 768 + g * 64 + col]);
      y[(size_t)row * 1024 + 768 + g * 64 + col] = f2bf((v[r] + bs[i]) * u * silu_f(gt));
    }
  }
};
struct EpiOut {
  KP p; int l;
  __device__ __forceinline__ void operator()(int row0, int col, f32x4 v) const {
    const int mr = row0 < NLAT ? (row0 >> 11) : 8;
    const float gm = p->mod[(size_t)(l * 9 + mr) * 3072 + 2048 + col];
#pragma unroll
    for (int r = 0; r < 4; ++r) {
      const int row = row0 + r;
      const float xo = xsrc_row(p, l, row)[col];
      xdst_row(p, row)[col] = xo + gm * v[r];
    }
  }
};


enum { EK_IN = 0, EK_Q, EK_KV, EK_DFT, EK_GATED, EK_OUT, EK_SGU };
struct EpiAny {
  int kind, l, i0, i1, i2, i3;
  const float* f0;
};

template <int NT>
__device__ __forceinline__ void gemm_tile(const bf16_t* __restrict__ A, int lda, const bf16_t* __restrict__ Bt, int ldb,
                                          int K, int m0, int n0, KP p, const EpiAny& e, bf16_t* smem) {
  bf16_t* sA = smem;
  bf16_t* sB = smem + 128 * LSTR;
  const int tid = tid_opaque(), lane = tid & 63, wid = tid >> 6, wm = wid >> 1, wn = wid & 1;
  const int lr = tid >> 3, lc = (tid & 7) * 8;
  const bf16_t* Ap = A + (size_t)(m0 + lr) * lda + lc;
  const bf16_t* Bp = Bt + (size_t)(n0 + lr) * ldb + lc;
  u32x4 ra[2][4], rb[2][NT];
  f32x4 acc[4][NT];
#pragma unroll
  for (int i = 0; i < 4; ++i)
#pragma unroll
    for (int j = 0; j < NT; ++j) acc[i][j] = f32x4{0.f, 0.f, 0.f, 0.f};
  const int nk = K >> 6;
#pragma unroll
  for (int st = 0; st < 2; ++st) {
#pragma unroll
    for (int i = 0; i < 4; ++i) ra[st][i] = *(const u32x4*)(Ap + (size_t)i * 32 * lda + st * 64);
#pragma unroll
    for (int i = 0; i < NT; ++i) rb[st][i] = *(const u32x4*)(Bp + (size_t)i * 32 * ldb + st * 64);
  }
  const int l15 = lane & 15, g4 = lane >> 4;
  for (int kt = 0; kt < nk; kt += 2) {
#pragma unroll
    for (int st = 0; st < 2; ++st) {
      __syncthreads();
#pragma unroll
      for (int i = 0; i < 4; ++i) *(u32x4*)(sA + (lr + i * 32) * LSTR + lc) = ra[st][i];
#pragma unroll
      for (int i = 0; i < NT; ++i) *(u32x4*)(sB + (lr + i * 32) * LSTR + lc) = rb[st][i];
      __syncthreads();
      if (kt + st + 2 < nk) {
        const int ko = (kt + st + 2) * 64;
#pragma unroll
        for (int i = 0; i < 4; ++i) ra[st][i] = *(const u32x4*)(Ap + (size_t)i * 32 * lda + ko);
#pragma unroll
        for (int i = 0; i < NT; ++i) rb[st][i] = *(const u32x4*)(Bp + (size_t)i * 32 * ldb + ko);
      }
#pragma unroll
      for (int ks = 0; ks < 2; ++ks) {
        bf16x8 af[4], bfr[NT];
#pragma unroll
        for (int i = 0; i < 4; ++i) af[i] = *(const bf16x8*)(sA + (wm * 64 + i * 16 + l15) * LSTR + ks * 32 + g4 * 8);
#pragma unroll
        for (int j = 0; j < NT; ++j) bfr[j] = *(const bf16x8*)(sB + (wn * (NT * 16) + j * 16 + l15) * LSTR + ks * 32 + g4 * 8);
#pragma unroll
        for (int i = 0; i < 4; ++i)
#pragma unroll
          for (int j = 0; j < NT; ++j) acc[i][j] = __builtin_amdgcn_mfma_f32_16x16x32_bf16(af[i], bfr[j], acc[i][j], 0, 0, 0);
      }
    }
  }
  const int rbase = m0 + wm * 64 + g4 * 4, cbase = n0 + wn * (NT * 16) + l15;
#define EPI_LOOP(EXPR)                                   \
  _Pragma("unroll") for (int i = 0; i < 4; ++i)          \
  _Pragma("unroll") for (int j = 0; j < NT; ++j) {       \
    const int row0 = rbase + i * 16, col = cbase + j * 16; \
    const f32x4 v = acc[i][j];                           \
    EXPR;                                                \
  }
  if constexpr (NT == 2) {
    EpiSGU ep{p->y, p->hp, e.f0, e.i0, e.i1};
    EPI_LOOP(ep(row0, col, v));
  } else {
    switch (e.kind) {
      case EK_IN: { EpiIn ep{p->hp, p->XT, p->XTc}; EPI_LOOP(ep(row0, col, v)); } break;
      case EK_Q: { EpiQ ep{p->q, p->qc, p->rstdq}; EPI_LOOP(ep(row0, col, v)); } break;
      case EK_KV: { EpiKV ep{p->kall, p->vT, p->rstdkv}; EPI_LOOP(ep(row0, col, v)); } break;
      case EK_DFT: { EpiDFT ep{p->T, e.i0, e.i1, e.i2, e.i3}; EPI_LOOP(ep(row0, col, v)); } break;
      case EK_GATED: { EpiGated ep{p->y, p->hp, e.f0, e.i0, e.i1}; EPI_LOOP(ep(row0, col, v)); } break;
      default: { EpiOut ep{p, e.l}; EPI_LOOP(ep(row0, col, v)); } break;
    }
  }
#undef EPI_LOOP
}

__device__ __forceinline__ size_t frag_off(int n, int k, int K) {
  return ((size_t)(n >> 4) * (K >> 5) + (k >> 5)) * 512 + ((((k & 31) >> 3) * 16) + (n & 15)) * 8 + (k & 7);
}

__device__ __forceinline__ void gemm_bd(const bf16_t* __restrict__ A, int lda, const bf16_t* __restrict__ Bf, int K, int m0, int n0,
                                        KP p, const EpiAny& e, bf16_t* smem) {
  const int tid = tid_opaque(), lane = tid & 63, wn = tid >> 6;
  const int lr = tid >> 3, lc = (tid & 7) * 8;
  const int l15 = lane & 15, g4 = lane >> 4;
  const bf16_t* Ap = A + (size_t)(m0 + lr) * lda + lc;
  const size_t jstr = (size_t)(K >> 5) * 512;
  const bf16_t* Bp = Bf + (size_t)((n0 >> 4) + wn * 2) * jstr + lane * 8;
  bf16_t* sA0 = smem;
  bf16_t* sA1 = smem + 128 * LSTR;
  u32x4 ra[4], b0[2][2], b1[2][2];
  f32x4 acc[8][2];
#pragma unroll
  for (int i = 0; i < 8; ++i)
#pragma unroll
    for (int j = 0; j < 2; ++j) acc[i][j] = f32x4{0.f, 0.f, 0.f, 0.f};
  const int nk = K >> 6;
#pragma unroll
  for (int i = 0; i < 4; ++i) ra[i] = *(const u32x4*)(Ap + (size_t)i * 32 * lda);
  __syncthreads();
#pragma unroll
  for (int i = 0; i < 4; ++i) *(u32x4*)(sA0 + (lr + i * 32) * LSTR + lc) = ra[i];
  __builtin_amdgcn_sched_barrier(0);
#pragma unroll
  for (int i = 0; i < 4; ++i) ra[i] = *(const u32x4*)(Ap + (size_t)i * 32 * lda + 64);
#pragma unroll
  for (int j = 0; j < 2; ++j)
#pragma unroll
    for (int ks = 0; ks < 2; ++ks) b0[j][ks] = *(const u32x4*)(Bp + j * jstr + ks * 512);
  __builtin_amdgcn_sched_barrier(0);
  __syncthreads();
#define GBD_STEP(SCUR, SNEXT, BC, BN, KT)                                                                   \
  {                                                                                                         \
    const int k1 = ((KT) + 1 < nk) ? (KT) + 1 : nk - 1;         \
    const int k2 = ((KT) + 2 < nk) ? (KT) + 2 : nk - 1;                                                     \
    _Pragma("unroll") for (int i = 0; i < 4; ++i) *(u32x4*)(SNEXT + (lr + i * 32) * LSTR + lc) = ra[i];     \
      \
    bf16x8 af[2][8];                                                                                        \
    _Pragma("unroll") for (int ks = 0; ks < 2; ++ks)                                                        \
    _Pragma("unroll") for (int i = 0; i < 8; ++i)                                                           \
      af[ks][i] = *(const bf16x8*)(SCUR + (i * 16 + l15) * LSTR + ks * 32 + g4 * 8);                        \
    __builtin_amdgcn_sched_barrier(0);                                                                      \
    _Pragma("unroll") for (int i = 0; i < 4; ++i)                                                           \
      ra[i] = *(const u32x4*)(Ap + (size_t)i * 32 * lda + k2 * 64);                                         \
    _Pragma("unroll") for (int j = 0; j < 2; ++j)                                                           \
    _Pragma("unroll") for (int ks = 0; ks < 2; ++ks)                                                        \
      BN[j][ks] = *(const u32x4*)(Bp + j * jstr + (size_t)(k1 * 2 + ks) * 512);                             \
    __builtin_amdgcn_sched_barrier(0);                                                                      \
    __builtin_amdgcn_s_setprio(1);                                                                          \
    _Pragma("unroll") for (int ks = 0; ks < 2; ++ks)                                                        \
    _Pragma("unroll") for (int i = 0; i < 8; ++i)                                                           \
    _Pragma("unroll") for (int j = 0; j < 2; ++j)                                                           \
      acc[i][j] = __builtin_amdgcn_mfma_f32_16x16x32_bf16(af[ks][i], __builtin_bit_cast(bf16x8, BC[j][ks]), acc[i][j], 0, 0, 0); \
    __builtin_amdgcn_s_setprio(0);                                                                          \
    __syncthreads();                                                                                        \
  }
  for (int kt = 0; kt < nk; kt += 2) {
    GBD_STEP(sA0, sA1, b0, b1, kt)
    GBD_STEP(sA1, sA0, b1, b0, kt + 1)
  }
#undef GBD_STEP
  if (e.kind == EK_OUT || e.kind == EK_GATED || (e.kind == EK_IN && n0 < HPS)) {
    float* stg = (float*)smem;
    const int rr = tid >> 2, c0 = (tid & 3) * 32;
#pragma unroll
    for (int half = 0; half < 2; ++half) {
      if (half) __syncthreads();
#pragma unroll
      for (int ii = 0; ii < 4; ++ii)
#pragma unroll
        for (int j = 0; j < 2; ++j)
#pragma unroll
          for (int r = 0; r < 4; ++r) stg[(ii * 16 + g4 * 4 + r) * 132 + wn * 32 + j * 16 + l15] = acc[half * 4 + ii][j][r];
      __syncthreads();
      const int row = m0 + half * 64 + rr, col = n0 + c0;
      float4 v[8];
#pragma unroll
      for (int k = 0; k < 8; ++k) v[k] = *(const float4*)(stg + rr * 132 + c0 + k * 4);
      if (e.kind == EK_OUT) {
        const int mr = row < NLAT ? (row >> 11) : 8;
        const float* gm = p->mod + (size_t)(e.l * 9 + mr) * 3072 + 2048 + col;
        const float* xs = xsrc_row(p, e.l, row) + col;
        float* xd = xdst_row(p, row) + col;
#pragma unroll
        for (int k = 0; k < 8; ++k) {
          const float4 xo = *(const float4*)(xs + k * 4);
          const float4 g = *(const float4*)(gm + k * 4);
          float4 o;
          o.x = xo.x + g.x * v[k].x; o.y = xo.y + g.y * v[k].y; o.z = xo.z + g.z * v[k].z; o.w = xo.w + g.w * v[k].w;
          *(float4*)(xd + k * 4) = o;
        }
      } else if (e.kind == EK_IN) {
        bf16_t* dst = p->hp + (size_t)row * HPS + col;
#pragma unroll
        for (int k = 0; k < 4; ++k) {
          u32x4 u;
          u[0] = pack2(v[2 * k].x, v[2 * k].y); u[1] = pack2(v[2 * k].z, v[2 * k].w);
          u[2] = pack2(v[2 * k + 1].x, v[2 * k + 1].y); u[3] = pack2(v[2 * k + 1].z, v[2 * k + 1].w);
          *(u32x4*)(dst + k * 8) = u;
        }
      } else {
        const bf16_t* gp = p->hp + (size_t)row * HPS + e.i0 + col;
        const float* bp = e.f0 + col;
        bf16_t* dst = p->y + (size_t)row * 1024 + e.i1 + col;
#pragma unroll
        for (int k = 0; k < 4; ++k) {
          const u32x4 gu = *(const u32x4*)(gp + k * 8);
          const float4 ba = *(const float4*)(bp + k * 8), bb = *(const float4*)(bp + k * 8 + 4);
          u32x4 u;
          u[0] = pack2((v[2 * k].x + ba.x) * silu_f(bf2f((bf16_t)(gu[0] & 0xffff))), (v[2 * k].y + ba.y) * silu_f(bf2f((bf16_t)(gu[0] >> 16))));
          u[1] = pack2((v[2 * k].z + ba.z) * silu_f(bf2f((bf16_t)(gu[1] & 0xffff))), (v[2 * k].w + ba.w) * silu_f(bf2f((bf16_t)(gu[1] >> 16))));
          u[2] = pack2((v[2 * k + 1].x + bb.x) * silu_f(bf2f((bf16_t)(gu[2] & 0xffff))), (v[2 * k + 1].y + bb.y) * silu_f(bf2f((bf16_t)(gu[2] >> 16))));
          u[3] = pack2((v[2 * k + 1].z + bb.z) * silu_f(bf2f((bf16_t)(gu[3] & 0xffff))), (v[2 * k + 1].w + bb.w) * silu_f(bf2f((bf16_t)(gu[3] >> 16))));
          *(u32x4*)(dst + k * 8) = u;
        }
      }
    }
    return;
  }
  const int rbase = m0 + g4 * 4, cbase = n0 + wn * 32 + l15;
#define EPI_LOOP(EXPR)                                   \
  _Pragma("unroll") for (int i = 0; i < 8; ++i)          \
  _Pragma("unroll") for (int j = 0; j < 2; ++j) {        \
    const int row0 = rbase + i * 16, col = cbase + j * 16; \
    const f32x4 v = acc[i][j];                           \
    EXPR;                                                \
  }
  switch (e.kind) {
    case EK_IN: { EpiIn ep{p->hp, p->XT, p->XTc}; EPI_LOOP(ep(row0, col, v)); } break;
    case EK_Q: { EpiQ ep{p->q, p->qc, p->rstdq}; EPI_LOOP(ep(row0, col, v)); } break;
    case EK_KV: { EpiKV ep{p->kall, p->vT, p->rstdkv}; EPI_LOOP(ep(row0, col, v)); } break;
    case EK_DFT: { EpiDFT ep{p->T, e.i0, e.i1, e.i2, e.i3}; EPI_LOOP(ep(row0, col, v)); } break;
    case EK_GATED: { EpiGated ep{p->y, p->hp, e.f0, e.i0, e.i1}; EPI_LOOP(ep(row0, col, v)); } break;
    default: { EpiOut ep{p, e.l}; EPI_LOOP(ep(row0, col, v)); } break;
  }
#undef EPI_LOOP
}

__device__ __forceinline__ void tconv32(const float* __restrict__ src, int src_ld, int k0, int ns0, bf16_t* dst, int dst_ld,
                                        int nd0, const float* kscale, float scale, float* sm) {
  const int tid = tid_opaque();
  __syncthreads();
  if (ns0 >= 0) {
    const int n = tid & 31, kk = tid >> 5;
#pragma unroll
    for (int i = 0; i < 8; ++i) {
      const int k = kk + 8 * i;
      float v = src[(size_t)(k0 + k) * src_ld + ns0 + n] * scale;
      if (kscale) v *= kscale[k0 + k];
      sm[k * 33 + n] = v;
    }
  }
  __syncthreads();
  const int n2 = tid >> 3, kc = (tid & 7) * 8;
  uint4 u = make_uint4(0, 0, 0, 0);
  if (ns0 >= 0) {
    u.x = pack2(sm[(kc + 0) * 33 + n2], sm[(kc + 1) * 33 + n2]);
    u.y = pack2(sm[(kc + 2) * 33 + n2], sm[(kc + 3) * 33 + n2]);
    u.z = pack2(sm[(kc + 4) * 33 + n2], sm[(kc + 5) * 33 + n2]);
    u.w = pack2(sm[(kc + 6) * 33 + n2], sm[(kc + 7) * 33 + n2]);
  }
  *(uint4*)(dst + frag_off(nd0 + n2, k0 + kc, dst_ld)) = u;
}

__device__ __forceinline__ void tconv32x4(const float* __restrict__ src, int src_ld, int k0, int ns0, bf16_t* dst, int dst_ld,
                                          int nd0, float* sm) {
  const int tid = tid_opaque();
  const int n = tid & 31, kk = tid >> 5;
  float v[4][8];
  if (ns0 >= 0) {
#pragma unroll
    for (int t = 0; t < 4; ++t)
#pragma unroll
      for (int i = 0; i < 8; ++i) v[t][i] = src[(size_t)(k0 + t * 64 + kk + 8 * i) * src_ld + ns0 + n];
  } else {
#pragma unroll
    for (int t = 0; t < 4; ++t)
#pragma unroll
      for (int i = 0; i < 8; ++i) v[t][i] = 0.f;
  }
  const int n2 = tid >> 3, kc = (tid & 7) * 8;
#pragma unroll
  for (int t = 0; t < 4; ++t) {
    __syncthreads();
#pragma unroll
    for (int i = 0; i < 8; ++i) sm[(kk + 8 * i) * 33 + n] = v[t][i];
    __syncthreads();
    uint4 u;
    u.x = pack2(sm[(kc + 0) * 33 + n2], sm[(kc + 1) * 33 + n2]);
    u.y = pack2(sm[(kc + 2) * 33 + n2], sm[(kc + 3) * 33 + n2]);
    u.z = pack2(sm[(kc + 4) * 33 + n2], sm[(kc + 5) * 33 + n2]);
    u.w = pack2(sm[(kc + 6) * 33 + n2], sm[(kc + 7) * 33 + n2]);
    *(uint4*)(dst + frag_off(nd0 + n2, k0 + t * 64 + kc, dst_ld)) = u;
  }
}
constexpr int NW_ITEMS = 88 * 4 + 32 * 4 + 12 * 4 + 16 * 2 + 8 * 4 + 512 + 32;
__device__ void wconv_item(KP p, int l, int i, char* smem) {
  const int tid = tid_opaque();
  const int n_win = 88 * 4, n_wout = 32 * 4, n_wuq = 12 * 4, n_wukv = 16 * 2, n_wpw = 8 * 4, n_wf = 512;
  const int par = l & 1;
  float* sm = (float*)smem;
  if (i < n_win) {
    const int d = i >> 2, kq = i & 3;
    int s;
    if (d < 12) s = d; else if (d < 28) s = d + 1; else if (d < 76) s = d + 9; else if (d == 76) s = 12; else if (d < 80) s = -1; else s = d - 51;
    tconv32x4(p->w_in + (size_t)l * 1024 * 2720, 2720, kq * 256, s < 0 ? -1 : s * 32, p->WinT, 1024, d * 32, sm);
    return;
  }
  i -= n_win;
  if (i < n_wout) {
    const int d = i >> 2, kq = i & 3;
    tconv32x4(p->w_out + (size_t)l * 1024 * 1024, 1024, kq * 256, d * 32, p->WoutT + (size_t)par * 1024 * 1024, 1024, d * 32, sm);
    return;
  }
  i -= n_wout;
  if (i < n_wuq) {
    const int d = i >> 2, kt = i & 3;
    tconv32(p->w_uq + (size_t)l * 256 * 384, 384, kt * 64, d * 32, p->WuqT + (size_t)par * 384 * 256, 256, d * 32, p->q_norm_g + l * 256,
            0.10206207261596577f * 1.4426950408889634f, sm);
    return;
  }
  i -= n_wuq;
  if (i < n_wukv) {
    const int d = i >> 1, kt = i & 1;
    tconv32(p->w_ukv + (size_t)l * 128 * 512, 512, kt * 64, d * 32, p->WukvT + (size_t)par * 512 * 128, 128, d * 32, p->kv_norm_g + l * 128, 1.f, sm);
    return;
  }
  i -= n_wukv;
  if (i < n_wpw) {
    const int d = i >> 2, kt = i & 3;
    tconv32(p->w_pw + (size_t)l * 256 * 256, 256, kt * 64, d * 32, p->WpwT + (size_t)par * 65536, 256, d * 32, nullptr, 1.f, sm);
    return;
  }
  i -= n_wpw;
  if (i < n_wf) {
    float* tab = (float*)smem;
    __syncthreads();
    if (tid < 64) { tab[tid] = cospif((float)tid * (1.f / 32.f)); tab[64 + tid] = sinpif((float)tid * (1.f / 32.f)); }
    __syncthreads();
    const int o = i * 256 + tid;
    const int n = o & 255, kk = o >> 8;
    const int half = kk >> 8, gc = kk & 255, g = gc >> 6, c = gc & 63;
    const float* wf = p->w_fourier + (size_t)l * 65536 + (size_t)(g * 64) * 256 + n;
    float acc = 0.f;
#pragma unroll 8
    for (int m = 0; m < 64; ++m) {
      const int j = (c * m) & 63;
      const float tv = half ? -tab[64 + j] : tab[j];
      acc += tv * wf[(size_t)m * 256];
    }
    p->WfT[(size_t)par * 256 * 512 + frag_off(n, kk, 512)] = f2bf(acc * 0.125f);
    return;
  }
  i -= n_wf;
  {
    const int o = (i * 256 + tid) * 8;
    const float* s = p->w_s + (size_t)l * 65536 + o;
    const float4 a = *(const float4*)s, b = *(const float4*)(s + 4);
    *(uint4*)(p->Wsb + (size_t)par * 65536 + o) = make_uint4(pack2(a.x, a.y), pack2(a.z, a.w), pack2(b.x, b.y), pack2(b.z, b.w));
  }
}

__device__ void phase0(KP p, char* smem) {
  const int tid = tid_opaque();
  const int n_dft = 2048, n_dft2 = 512, n_ada = 768;
  const int total = n_ada + n_dft + n_dft2 + NW_ITEMS;
  for (int it = blockIdx.x; it < total; it += gridDim.x) {
    if (it >= n_ada + n_dft + n_dft2) { wconv_item(p, 0, it - (n_ada + n_dft + n_dft2), smem); continue; }
    if (it < n_ada) {
      const int l = it / 192, nb = it % 192;
      float* sm_s = (float*)smem;
      float* red = sm_s + 9 * 1024;
      __syncthreads();
      for (int idx = tid; idx < 9216; idx += 256) {
        const int r = idx >> 10, k = idx & 1023;
        const float cv = r < 8 ? p->c[r * 1024 + k] : p->c_ctx[k];
        sm_s[idx] = silu_f(cv);
      }
      __syncthreads();
      const int col = tid & 15, ks = tid >> 4;
      const int n = nb * 16 + col;
      float acc[9];
#pragma unroll
      for (int r = 0; r < 9; ++r) acc[r] = 0.f;
      const float* wp = p->w_ada + ((size_t)l * 1024 + ks * 64) * 3072 + n;
#pragma unroll
      for (int hb = 0; hb < 2; ++hb) {
        float w[32];
#pragma unroll
        for (int kk = 0; kk < 32; ++kk) w[kk] = wp[(size_t)(hb * 32 + kk) * 3072];
#pragma unroll
        for (int kk = 0; kk < 32; ++kk) {
          const int k = ks * 64 + hb * 32 + kk;
#pragma unroll
          for (int r = 0; r < 9; ++r) acc[r] += sm_s[r * 1024 + k] * w[kk];
        }
      }
#pragma unroll
      for (int r = 0; r < 9; ++r) red[(ks * 16 + col) * 9 + r] = acc[r];
      __syncthreads();
      if (tid < 144) {
        const int r = tid >> 4, c2 = tid & 15;
        float s = 0.f;
        for (int k2 = 0; k2 < 16; ++k2) s += red[(k2 * 16 + c2) * 9 + r];
        const int n2 = nb * 16 + c2;
        p->mod[(size_t)(l * 9 + r) * 3072 + n2] = s + p->b_ada[l * 3072 + n2];
      }
    } else if (it < n_ada + n_dft) {
      const int m = it - n_ada;
      const int half = m >> 10, kp = m & 1023;
      const float sc = 0.02209708691207961f;
      unsigned w[4];
#pragma unroll
      for (int e = 0; e < 4; ++e) {
        float v2[2];
#pragma unroll
        for (int e2 = 0; e2 < 2; ++e2) {
          const int n = tid * 8 + e * 2 + e2;
          const int j = (kp * n) & 2047;
          const float a = (float)j * (1.f / 1024.f);
          v2[e2] = (half ? sinpif(a) : cospif(a)) * sc;
        }
        w[e] = pack2(v2[0], v2[1]);
      }
      *(uint4*)(p->CS2048 + frag_off(m, tid * 8, 2048)) = make_uint4(w[0], w[1], w[2], w[3]);
    } else {
      const int m = it - n_ada - n_dft;
      const int half = m >> 8, kp = m & 255;
      const int n = tid;
      const int j = (kp * n) & 255;
      const float a = (float)j * (1.f / 128.f);
      p->CS256[frag_off(m, n, 256)] = f2bf((half ? sinpif(a) : cospif(a)) * 0.0625f);
    }
  }
}

__device__ void phaseA(KP p, int l, char* smem) {
  const int tid = tid_opaque(), lane = tid & 63, wid = tid >> 6;
  for (int it = blockIdx.x; it < NROW / 8; it += gridDim.x) {
    const int row0 = it * 8 + wid * 2;
    float4 v[2][4];
    float ss[2];
#pragma unroll
    for (int rr = 0; rr < 2; ++rr) {
      const float* xr = xsrc_row(p, l, row0 + rr);
      ss[rr] = 0.f;
#pragma unroll
      for (int e = 0; e < 4; ++e) v[rr][e] = *(const float4*)(xr + e * 256 + lane * 4);
    }
    const int mr = row0 < NLAT ? (row0 >> 11) : 8;
    const float* md = p->mod + (size_t)(l * 9 + mr) * 3072;
    const float* ng = p->norm_g + l * 1024;
#pragma unroll
    for (int rr = 0; rr < 2; ++rr) {
#pragma unroll
      for (int e = 0; e < 4; ++e)
        ss[rr] += v[rr][e].x * v[rr][e].x + v[rr][e].y * v[rr][e].y + v[rr][e].z * v[rr][e].z + v[rr][e].w * v[rr][e].w;
      ss[rr] = wave_sum(ss[rr]);
    }
#pragma unroll
    for (int e = 0; e < 4; ++e) {
      const int k = e * 256 + lane * 4;
      const float4 g = *(const float4*)(ng + k);
      const float4 sh = *(const float4*)(md + k);
      const float4 sc = *(const float4*)(md + 1024 + k);
#pragma unroll
      for (int rr = 0; rr < 2; ++rr) {
        const float rstd = rsqrtf(ss[rr] * (1.f / 1024.f) + 1e-6f);
        uint2 u;
        u.x = pack2(v[rr][e].x * rstd * g.x * (1.f + sc.x) + sh.x, v[rr][e].y * rstd * g.y * (1.f + sc.y) + sh.y);
        u.y = pack2(v[rr][e].z * rstd * g.z * (1.f + sc.z) + sh.z, v[rr][e].w * rstd * g.w * (1.f + sc.w) + sh.w);
        *(uint2*)(p->h + (size_t)(row0 + rr) * 1024 + k) = u;
      }
    }
  }
}

__device__ void phaseC_rows(KP p, int l, int item, char* smem) {
  const int tid = tid_opaque(), lane = tid & 63, wid = tid >> 6;
  bf16_t* vt = (bf16_t*)smem;
  const int r0 = item * 64;
  __syncthreads();
  const float* lg = p->sgu_ln_g + l * 256;
  const float* lb = p->sgu_ln_b + l * 256;
  const float4 g4v = *(const float4*)(lg + lane * 4);
  const float4 b4v = *(const float4*)(lb + lane * 4);
  for (int rr = 0; rr < 16; ++rr) {
    const int tok = wid * 16 + rr;
    const int row = r0 + tok;
    const bf16_t* hr = p->hp + (size_t)row * HPS;
    {
      const uint2 u = *(const uint2*)(hr + HQ + lane * 4);
      const float a0 = bf2f(u.x & 0xffff), a1 = bf2f(u.x >> 16), a2 = bf2f(u.y & 0xffff), a3 = bf2f(u.y >> 16);
      const float ss = wave_sum(a0 * a0 + a1 * a1 + a2 * a2 + a3 * a3);
      if (lane == 0) p->rstdq[row] = rsqrtf(ss * (1.f / 256.f) + 1e-6f);
    }
    {
      const unsigned u = *(const unsigned*)(hr + HKV + lane * 2);
      const float a0 = bf2f(u & 0xffff), a1 = bf2f(u >> 16);
      const float ss = wave_sum(a0 * a0 + a1 * a1);
      if (lane == 0) p->rstdkv[row] = rsqrtf(ss * (1.f / 128.f) + 1e-6f);
    }
    {
      const uint2 u = *(const uint2*)(hr + HSGU + 256 + lane * 4);
      const float a0 = bf2f(u.x & 0xffff), a1 = bf2f(u.x >> 16), a2 = bf2f(u.y & 0xffff), a3 = bf2f(u.y >> 16);
      const float s1 = wave_sum(a0 + a1 + a2 + a3);
      const float mu = s1 * (1.f / 256.f);
      const float d0 = a0 - mu, d1 = a1 - mu, d2 = a2 - mu, d3 = a3 - mu;
      const float s2 = wave_sum(d0 * d0 + d1 * d1 + d2 * d2 + d3 * d3);
      const float rs = rsqrtf(s2 * (1.f / 256.f) + 1e-5f);
      vt[(lane * 4 + 0) * LSTR + tok] = f2bf(d0 * rs * g4v.x + b4v.x);
      vt[(lane * 4 + 1) * LSTR + tok] = f2bf(d1 * rs * g4v.y + b4v.y);
      vt[(lane * 4 + 2) * LSTR + tok] = f2bf(d2 * rs * g4v.z + b4v.z);
      vt[(lane * 4 + 3) * LSTR + tok] = f2bf(d3 * rs * g4v.w + b4v.w);
    }
    {
      const float own = (lane < 32) ? bf2f(hr[HROPE + lane]) : 0.f;
      const float par = __shfl_xor(own, 8);
      float outv = own;
      int b, pos;
      if (row < NLAT) {
        b = row >> 11; const int s = row & 2047; pos = s;
        const int axis = (lane >> 4) & 1, idx = lane & 15, f = idx & 7, isx2 = idx >> 3;
        const float ang = (float)(axis == 0 ? (s >> 6) : (s & 63)) * rope_inv(f);
        float sn, cs;
        sincosf(ang, &sn, &cs);
        outv = isx2 ? (par * sn + own * cs) : (own * cs - par * sn);
      } else { const int rr2 = row - NLAT; b = rr2 >> 8; pos = 2048 + (rr2 & 255); }
      if (lane < 32) {
        const bf16_t ov = f2bf(outv);
#pragma unroll
        for (int h = 0; h < 4; ++h) p->kall[((size_t)(b * 4 + h) * 2304 + pos) * 96 + 64 + lane] = ov;
      }
    }
  }
  __syncthreads();
  {
    const int chunk = r0 >> 7, toff = r0 & 127;
    bf16_t* dst = p->vnT + ((size_t)chunk * 256 + tid) * 128 + toff;
#pragma unroll
    for (int e = 0; e < 8; ++e) *(uint4*)(dst + e * 8) = *(const uint4*)(vt + tid * LSTR + e * 8);
  }
}

__device__ void phaseC_conv(KP p, int l, int item, char* smem) {
  const int tid = tid_opaque(), lane = tid & 63, wid = tid >> 6;
  bf16_t* glu = (bf16_t*)smem;
  float* part = (float*)(smem + 94 * 256 * 2);
  int rb, t0, slen;
  if (item < 256) { rb = (item >> 5) * 2048; t0 = (item & 31) * 64; slen = 2048; }
  else { const int i2 = item - 256; rb = NLAT + (i2 >> 2) * 256; t0 = (i2 & 3) * 64; slen = 256; }
  const int c = tid;
  __syncthreads();
#pragma unroll
  for (int half = 0; half < 2; ++half) {
    u32x4 av[6], gv[6];
#pragma unroll
    for (int i = 0; i < 6; ++i) {
      const int pi = tid + 256 * (half * 6 + i);
      const int r = pi >> 5, c8 = (pi & 31) * 8;
      const int tok = t0 - 15 + r;
      av[i] = u32x4{0u, 0u, 0u, 0u};
      gv[i] = u32x4{0u, 0u, 0u, 0u};
      if (pi < 3008 && tok >= 0 && tok < slen) {
        const bf16_t* hr = p->hp + (size_t)(rb + tok) * HPS + HCONV + c8;
        av[i] = *(const u32x4*)hr;
        gv[i] = *(const u32x4*)(hr + 256);
      }
    }
#pragma unroll
    for (int i = 0; i < 6; ++i) {
      const int pi = tid + 256 * (half * 6 + i);
      const int r = pi >> 5, c8 = (pi & 31) * 8;
      u32x4 o;
#pragma unroll
      for (int e = 0; e < 4; ++e) {
        const float a0 = bf2f((bf16_t)(av[i][e] & 0xffff)), a1 = bf2f((bf16_t)(av[i][e] >> 16));
        const float g0 = bf2f((bf16_t)(gv[i][e] & 0xffff)), g1 = bf2f((bf16_t)(gv[i][e] >> 16));
        o[e] = pack2(a0 * sigmoid_f(g0), a1 * sigmoid_f(g1));
      }
      if (pi < 3008) *(u32x4*)(glu + r * 256 + c8) = o;
    }
  }
  float w[31];
#pragma unroll
  for (int k = 0; k < 31; ++k) w[k] = p->conv_w[(size_t)(l * 31 + k) * 256 + c];
  const float cb = p->conv_b[l * 256 + c];
  const float lg = p->conv_ln_g[l * 256 + c], lb = p->conv_ln_b[l * 256 + c];
  __syncthreads();
  for (int blk = 0; blk < 8; ++blk) {
    const int tb = blk * 8, par = blk & 1;
    float g[38];
#pragma unroll
    for (int i = 0; i < 38; ++i) g[i] = bf2f(glu[(tb + i) * 256 + c]);
    float yv[8];
#pragma unroll
    for (int j = 0; j < 8; ++j) {
      float a = cb;
#pragma unroll
      for (int k = 0; k < 31; ++k) a += w[k] * g[j + k];
      yv[j] = a;
    }
#pragma unroll
    for (int j = 0; j < 8; ++j) {
      const float s1 = wave_sum(yv[j]);
      const float s2 = wave_sum(yv[j] * yv[j]);
      if (lane == 0) { part[((par * 8 + j) * 4 + wid) * 2 + 0] = s1; part[((par * 8 + j) * 4 + wid) * 2 + 1] = s2; }
    }
    __syncthreads();
#pragma unroll
    for (int j = 0; j < 8; ++j) {
      float s1 = 0.f, s2 = 0.f;
#pragma unroll
      for (int w2 = 0; w2 < 4; ++w2) { s1 += part[((par * 8 + j) * 4 + w2) * 2 + 0]; s2 += part[((par * 8 + j) * 4 + w2) * 2 + 1]; }
      const float mu = s1 * (1.f / 256.f);
      const float var = fmaxf(s2 * (1.f / 256.f) - mu * mu, 0.f);
      const float rs = rsqrtf(var + 1e-5f);
      const float z = (yv[j] - mu) * rs * lg + lb;
      p->convA[(size_t)(rb + t0 + tb + j) * 256 + c] = f2bf(silu_f(z));
    }
  }
}

__device__ void phaseC(KP p, int l, char* smem) {
  const int n_conv = 288, n_rows = 288;
  const int n_w = (l < 3) ? NW_ITEMS : 0;
  for (int it = blockIdx.x; it < n_conv + n_rows + n_w; it += gridDim.x) {
    if (it < n_conv) phaseC_conv(p, l, it, smem);
    else if (it < n_conv + n_rows) phaseC_rows(p, l, it - n_conv, smem);
    else wconv_item(p, l + 1, it - n_conv - n_rows, smem);
  }
}

__device__ void attn_item(KP p, int item, char* smem) {
  const int tid = tid_opaque(), lane = tid & 63, wid = tid >> 6, l15 = lane & 15, g4 = lane >> 4;
  bf16_t* sK = (bf16_t*)smem;
  bf16_t* sV = sK + 2 * 64 * KSTR;
  int b, h, qb, key0, nkeys, rowbase;
  const bf16_t* Qp;
  bool latent;
  if (item < 512) {
    b = item >> 6; h = (item >> 4) & 3; qb = item & 15; key0 = 0; nkeys = 2304; latent = true;
    Qp = p->q + ((size_t)(b * 4 + h) * 2048 + qb * 128) * 96; rowbase = b * 2048 + qb * 128;
  } else {
    const int i2 = item - 512;
    b = i2 >> 3; h = (i2 >> 1) & 3; qb = i2 & 1; key0 = 2048; nkeys = 256; latent = false;
    Qp = p->qc + ((size_t)(b * 4 + h) * 256 + qb * 128) * 96; rowbase = NLAT + b * 256 + qb * 128;
  }
  const bf16_t* Kp = p->kall + ((size_t)(b * 4 + h) * 2304 + key0) * 96;
  const bf16_t* Vp = p->vT + (size_t)(b * 4 + h) * 64 * 2304 + key0;

  bf16x8 qf[2][3];
#pragma unroll
  for (int qt = 0; qt < 2; ++qt)
#pragma unroll
    for (int d = 0; d < 3; ++d)
      qf[qt][d] = *(const bf16x8*)(Qp + (size_t)(wid * 32 + qt * 16 + l15) * 96 + d * 32 + g4 * 8);
  if (latent) {
#pragma unroll
    for (int qt = 0; qt < 2; ++qt) {
      const int s = qb * 128 + wid * 32 + qt * 16 + l15;
      const float pos = (float)((g4 < 2) ? (s >> 6) : (s & 63));
      bf16x8 o = qf[qt][2];
      bf16x8 r;
#pragma unroll
      for (int j = 0; j < 8; ++j) {
        const float own = bf2f((bf16_t)o[j]);
        const float par = __shfl_xor(own, 16);
        float sn, cs;
        sincosf(pos * rope_inv(j), &sn, &cs);
        const float ov = (g4 & 1) ? (par * sn + own * cs) : (own * cs - par * sn);
        r[j] = (short)f2bf(ov);
      }
      qf[qt][2] = r;
    }
  }

  u32x4 rk[3], rv[2];
  int koff[3], klds[3], voff[2], vlds[2];
#pragma unroll
  for (int i = 0; i < 3; ++i) {
    const int c = tid + 256 * i;
    const int krow = c / 12, cc = c % 12;
    koff[i] = krow * 96 + cc * 8;
    const int hh = krow >> 5, a = (krow >> 3) & 3, t = (krow >> 2) & 1, bb = krow & 3;
    klds[i] = (hh * 32 + t * 16 + a * 4 + bb) * KSTR + cc * 8;
  }
#pragma unroll
  for (int i = 0; i < 2; ++i) {
    const int c = tid + 256 * i;
    const int vrow = c >> 3, cc = c & 7;
    voff[i] = vrow * 2304 + cc * 8;
    vlds[i] = vrow * LSTR + cc * 8;
  }
  const int nt = nkeys >> 6;
#pragma unroll
  for (int i = 0; i < 3; ++i) rk[i] = *(const u32x4*)(Kp + koff[i]);
#pragma unroll
  for (int i = 0; i < 2; ++i) rv[i] = *(const u32x4*)(Vp + voff[i]);
  __syncthreads();
#pragma unroll
  for (int i = 0; i < 3; ++i) *(u32x4*)(sK + klds[i]) = rk[i];
#pragma unroll
  for (int i = 0; i < 2; ++i) *(u32x4*)(sV + vlds[i]) = rv[i];
  __syncthreads();

  float mrun[2] = {-1e30f, -1e30f}, lsum[2] = {0.f, 0.f};
  f32x4 O[2][4];
#pragma unroll
  for (int qt = 0; qt < 2; ++qt)
#pragma unroll
    for (int dv = 0; dv < 4; ++dv) O[qt][dv] = f32x4{0.f, 0.f, 0.f, 0.f};

  for (int it = 0; it < nt; ++it) {
    const int cur = it & 1;
    if (it + 1 < nt) {
      const bf16_t* Kn = Kp + (size_t)(it + 1) * 64 * 96;
      const bf16_t* Vn = Vp + (it + 1) * 64;
#pragma unroll
      for (int i = 0; i < 3; ++i) rk[i] = *(const u32x4*)(Kn + koff[i]);
#pragma unroll
      for (int i = 0; i < 2; ++i) rv[i] = *(const u32x4*)(Vn + voff[i]);
    }
    const bf16_t* cK = sK + cur * 64 * KSTR;
    const bf16_t* cV = sV + cur * 64 * LSTR;
    f32x4 s[2][4];
#pragma unroll
    for (int qt = 0; qt < 2; ++qt) {
#pragma unroll
      for (int k4 = 0; k4 < 4; ++k4) s[qt][k4] = f32x4{0.f, 0.f, 0.f, 0.f};
#pragma unroll
      for (int k4 = 0; k4 < 4; ++k4)
#pragma unroll
        for (int d = 0; d < 3; ++d) {
          const bf16x8 kf = *(const bf16x8*)(cK + (k4 * 16 + l15) * KSTR + d * 32 + g4 * 8);
          s[qt][k4] = __builtin_amdgcn_mfma_f32_16x16x32_bf16(kf, qf[qt][d], s[qt][k4], 0, 0, 0);
        }
    }
#pragma unroll
    for (int qt = 0; qt < 2; ++qt) {
      float mx = s[qt][0][0];
#pragma unroll
      for (int k4 = 0; k4 < 4; ++k4)
#pragma unroll
        for (int j = 0; j < 4; ++j) mx = fmaxf(mx, s[qt][k4][j]);
      mx = quad16_max(mx);
      const float mnew = fmaxf(mrun[qt], mx);
      const float alpha = __builtin_amdgcn_exp2f(mrun[qt] - mnew);
      mrun[qt] = mnew;
      float ps = 0.f;
#pragma unroll
      for (int k4 = 0; k4 < 4; ++k4)
#pragma unroll
        for (int j = 0; j < 4; ++j) {
          const float pv = __builtin_amdgcn_exp2f(s[qt][k4][j] - mnew);
          s[qt][k4][j] = pv;
          ps += pv;
        }
      lsum[qt] = lsum[qt] * alpha + ps;
#pragma unroll
      for (int dv = 0; dv < 4; ++dv) O[qt][dv] *= alpha;
      bf16x8 pf[2];
#pragma unroll
      for (int hh = 0; hh < 2; ++hh) {
        u32x4 t;
        t[0] = pack2(s[qt][hh * 2][0], s[qt][hh * 2][1]);
        t[1] = pack2(s[qt][hh * 2][2], s[qt][hh * 2][3]);
        t[2] = pack2(s[qt][hh * 2 + 1][0], s[qt][hh * 2 + 1][1]);
        t[3] = pack2(s[qt][hh * 2 + 1][2], s[qt][hh * 2 + 1][3]);
        pf[hh] = __builtin_bit_cast(bf16x8, t);
      }
#pragma unroll
      for (int dv = 0; dv < 4; ++dv)
#pragma unroll
        for (int hh = 0; hh < 2; ++hh) {
          const bf16x8 vf = *(const bf16x8*)(cV + (dv * 16 + l15) * LSTR + hh * 32 + g4 * 8);
          O[qt][dv] = __builtin_amdgcn_mfma_f32_16x16x32_bf16(vf, pf[hh], O[qt][dv], 0, 0, 0);
        }
    }
    if (it + 1 < nt) {
      bf16_t* nK = sK + (cur ^ 1) * 64 * KSTR;
      bf16_t* nV = sV + (cur ^ 1) * 64 * LSTR;
#pragma unroll
      for (int i = 0; i < 3; ++i) *(u32x4*)(nK + klds[i]) = rk[i];
#pragma unroll
      for (int i = 0; i < 2; ++i) *(u32x4*)(nV + vlds[i]) = rv[i];
    }
    __syncthreads();
  }
#pragma unroll
  for (int qt = 0; qt < 2; ++qt) {
    float lt = lsum[qt];
    lt = quad16_sum(lt);
    const float inv = 1.f / lt;
    const int row = rowbase + wid * 32 + qt * 16 + l15;
#pragma unroll
    for (int dv = 0; dv < 4; ++dv) {
      const int col = h * 64 + dv * 16 + g4 * 4;
      const uint2 gu = *(const uint2*)(p->hp + (size_t)row * HPS + HGATE + col);
      const float g0 = bf2f(gu.x & 0xffff), g1 = bf2f(gu.x >> 16), g2 = bf2f(gu.y & 0xffff), g3 = bf2f(gu.y >> 16);
      uint2 u;
      u.x = pack2(O[qt][dv][0] * inv * silu_f(g0), O[qt][dv][1] * inv * silu_f(g1));
      u.y = pack2(O[qt][dv][2] * inv * silu_f(g2), O[qt][dv][3] * inv * silu_f(g3));
      *(uint2*)(p->y + (size_t)row * 1024 + col) = u;
    }
  }
}

__device__ void phaseZ(KP p) {
  const int tid = tid_opaque(), lane = tid & 63, wid = tid >> 6;
  for (int it = blockIdx.x; it < NLAT / 4; it += gridDim.x) {
    const int row = it * 4 + wid;
    float* xr = p->out + (size_t)row * 1024;
    float4 v[4];
    float ss = 0.f;
#pragma unroll
    for (int e = 0; e < 4; ++e) {
      v[e] = *(const float4*)(xr + e * 256 + lane * 4);
      ss += v[e].x * v[e].x + v[e].y * v[e].y + v[e].z * v[e].z + v[e].w * v[e].w;
    }
    ss = wave_sum(ss);
    const float rstd = rsqrtf(ss * (1.f / 1024.f) + 1e-6f);
#pragma unroll
    for (int e = 0; e < 4; ++e) {
      const float4 g = *(const float4*)(p->final_g + e * 256 + lane * 4);
      float4 o;
      o.x = v[e].x * rstd * g.x; o.y = v[e].y * rstd * g.y; o.z = v[e].z * rstd * g.z; o.w = v[e].w * rstd * g.w;
      *(float4*)(xr + e * 256 + lane * 4) = o;
    }
  }
}


__device__ void dft_nyquist_item(KP p, int b, int part) {
  const int tid = tid_opaque();
  const int c = part * 64 + (tid >> 2), sub = tid & 3;
  const bf16_t* xr = p->XT + ((size_t)b * 256 + c) * 2048 + sub * 512;
  float acc = 0.f;
#pragma unroll 8
  for (int i = 0; i < 64; ++i) {
    const u32x4 u = *(const u32x4*)(xr + i * 8);
#pragma unroll
    for (int e2 = 0; e2 < 4; ++e2) acc += bf2f((bf16_t)(u[e2] & 0xffff)) - bf2f((bf16_t)(u[e2] >> 16));
  }
  acc += __shfl_xor(acc, 1);
  acc += __shfl_xor(acc, 2);
  if (sub == 0) {
    bf16_t* t = p->T + (size_t)(b * 2048 + 1024) * 512;
    t[c] = f2bf(acc * 0.02209708691207961f);
    t[256 + c] = 0;
  }
}

#define XB_TMO      128
#define XB_XCNT(j)  (256  + 64 * (j))
#define XB_XSUB(j)  (1280 + 64 * (j))
#define XB_XGEN(j)  (2304 + 64 * (j))
#define XB_TOP      3328
#define XB_TOPGEN   3392
#define XCD_BAR_WORDS 3456
#define XB_SPIN_CAP (1u << 20)
#define LAS __attribute__((address_space(3)))
__device__ __forceinline__ unsigned xb_ld(unsigned* p) { return __hip_atomic_load(p, __ATOMIC_RELAXED, __HIP_MEMORY_SCOPE_AGENT); }
__device__ __forceinline__ unsigned xb_add(unsigned* p, unsigned v) { return __hip_atomic_fetch_add(p, v, __ATOMIC_RELAXED, __HIP_MEMORY_SCOPE_AGENT); }
__device__ __forceinline__ unsigned xb_xcc_id() { return (unsigned)__builtin_amdgcn_s_getreg((3 << 11) | 20) & 0xFu; }
#define XB_SPIN(cond, bar) do { unsigned _sp = 0; while (cond) { __builtin_amdgcn_s_sleep(1); \
    if ((++_sp & 255u) == 0u) { if (xb_ld(&(bar)[XB_TMO])) break; if (_sp > XB_SPIN_CAP) { atomicAdd(&(bar)[XB_TMO], 1u); break; } } } } while (0)
struct XcdBarrier { unsigned* bar; unsigned x; volatile LAS unsigned* st; };
__device__ __forceinline__ XcdBarrier xcd_barrier_post(unsigned* bar, volatile LAS unsigned* st) {
  XcdBarrier b; b.bar = bar; b.x = xb_xcc_id(); b.st = st;
  if (threadIdx.x == 0) (void)xb_add(&bar[XB_XCNT(b.x)], 1u);
  return b;
}
__device__ __forceinline__ void xcd_barrier_complete(unsigned* bar, unsigned x, unsigned& nloc, unsigned& nx) {
  const unsigned G = gridDim.x * gridDim.y * gridDim.z;
  unsigned sum, cnt, mine, sp = 0u;
  for (;;) {
    sum = 0u; cnt = 0u; mine = 0u;
#pragma unroll
    for (unsigned j = 0; j < 16; ++j) { const unsigned c = xb_ld(&bar[XB_XCNT(j)]); sum += c; cnt += (c > 0u) ? 1u : 0u; mine = (j == x) ? c : mine; }
    if (sum == G) break;
    __builtin_amdgcn_s_sleep(1);
    if ((++sp & 255u) == 0u) { if (xb_ld(&bar[XB_TMO])) break; if (sp > XB_SPIN_CAP) { atomicAdd(&bar[XB_TMO], 1u); break; } }
  }
  nloc = mine > 0u ? mine : 1u; nx = cnt > 0u ? cnt : 1u;
}
__device__ __forceinline__ void xcd_barrier(const XcdBarrier& b) {
  asm volatile("s_waitcnt vmcnt(0)" ::: "memory");
  __syncthreads();
  if (threadIdx.x == 0) {
    unsigned* bar = b.bar;
    __builtin_amdgcn_s_waitcnt(0);
    unsigned nloc = b.st[0], nx = b.st[1];
    if (nloc == 0u) { xcd_barrier_complete(bar, b.x, nloc, nx); b.st[0] = nloc; b.st[1] = nx; }
    const unsigned old = xb_add(&bar[XB_XSUB(b.x)], 1u);
    const unsigned gen = old / nloc;
    if (old + 1u == (gen + 1u) * nloc) {
      __builtin_amdgcn_fence(__ATOMIC_RELEASE, "agent");
      asm volatile("s_waitcnt vmcnt(0)" ::: "memory");
      const unsigned og = xb_add(&bar[XB_TOP], 1u);
      const unsigned tg = og / nx;
      if (og + 1u == (tg + 1u) * nx) xb_add(&bar[XB_TOPGEN], 1u);
      else XB_SPIN(xb_ld(&bar[XB_TOPGEN]) == tg, bar);
      __builtin_amdgcn_fence(__ATOMIC_ACQUIRE, "agent");
      xb_add(&bar[XB_XGEN(b.x)], 1u);
      asm volatile("s_waitcnt vmcnt(0)" ::: "memory");
    } else {
      XB_SPIN(xb_ld(&bar[XB_XGEN(b.x)]) == gen, bar);
      __builtin_amdgcn_fence(__ATOMIC_ACQUIRE, "agent");
      asm volatile("s_waitcnt vmcnt(0)" ::: "memory");
    }
  }
  __syncthreads();
}

constexpr int N_PHASES = 26;
constexpr int SMEM_BYTES = 49152;

__device__ __forceinline__ int gemm_phase_items(int l, int s) {
  if (s == 1) return 144 * 22;
  if (s == 3) return 512 + 432 + 576 + 288 + 576 + 64;
  if (s == 4) return ((l == 3) ? 512 : 576) + 288;
  return (l == 3 ? 128 : 144) * 8;
}

template <bool COOP>
__global__ void __launch_bounds__(256, 2) mega(Params p_unused, int ph_lo, int ph_hi) {
  __shared__ __attribute__((aligned(16))) char smem[SMEM_BYTES];
  __shared__ uint4 xb_words;
  if (threadIdx.x == 0) xb_words = make_uint4(0u, 0u, 0u, 0u);
  __syncthreads();
  if (ph_lo < 0) cg::this_grid().sync();
  XcdBarrier xb = xcd_barrier_post(kparams()->bar, (volatile LAS unsigned*)&xb_words);
#ifndef PROBE_S
#define PROBE_S -1
#endif
#ifndef PROBE_SYNCS
#define PROBE_SYNCS 0
#endif
  for (int ph2 = ph_lo * 2; ph2 < ph_hi * 2; ++ph2) {
    const int ph = ph2 >> 1;
    if (ph2 & 1) {
      const bool rep = (PROBE_S == 6) ? (ph == 0) : ((PROBE_S >= 0) && ph != 0 && ph != N_PHASES - 1 && ((ph - 1) % 6) == PROBE_S);
      if (COOP && (rep || ph + 1 < ph_hi)) xcd_barrier(xb);
      if (!rep) continue;
    }
    KP p = kparams();
    if (ph == 0) phase0(p, smem);
    else if (ph == N_PHASES - 1) phaseZ(p);
    else {
      const int l = (ph - 1) / 6, s = (ph - 1) % 6;
      if (s == 0) phaseA(p, l, smem);
      else {
        const int xcd = blockIdx.x & 7, lrank = blockIdx.x >> 3, nl = gridDim.x >> 3;
        int nloc;
        if (s == 1) nloc = 396;
        else if (s == 2) nloc = 116 + ((l < 3) ? NW_ITEMS / 8 : 0);
        else if (s == 3) nloc = 270;
        else if (s == 4) nloc = (l == 3) ? 64 : 72;
        else nloc = (l == 3) ? 128 : 144;
        unsigned* qctr = kparams()->bar + XCD_BAR_WORDS + (ph2 * 8 + xcd) * 16;
        (void)lrank; (void)nl;
        for (;;) {
          __syncthreads();
          if (threadIdx.x == 0) xb_words.w = __hip_atomic_fetch_add(qctr, 1u, __ATOMIC_RELAXED, __HIP_MEMORY_SCOPE_AGENT);
          __syncthreads();
          const int q0 = (int)((volatile uint4*)&xb_words)->w;
          if (q0 >= nloc) break;
          KP p = kparams();
          const bf16_t *A, *Bt;
          int lda, ldb, K, m0, n0, nt4 = 1, isattn = 0, it = 0;
          EpiAny e{};
          e.l = l;
          int q = q0;
          if (s == 1) {
            const int mtl = (q / 66) * 3 + q % 3, nt = (q / 3) % 22;
            A = p->h; lda = 1024; Bt = p->WinT; ldb = 1024; K = 1024; m0 = (xcd * 18 + mtl) * 128; n0 = nt * 128; e.kind = EK_IN;
          } else if (s == 2) {
            if (q < 32) {
              const int b = xcd;
              A = p->XT + (size_t)b * 256 * 2048; lda = 2048; Bt = p->CS2048; ldb = 2048; K = 2048;
              m0 = (q & 1) * 128; n0 = (q >> 1) * 128; e.kind = EK_DFT; e.i0 = b * 2048; e.i1 = 1023; e.i2 = 10; e.i3 = 1;
            } else if (q < 68) { phaseC_conv(p, l, xcd * 36 + (q - 32), smem); continue; }
            else if (q < 104) { phaseC_rows(p, l, xcd * 36 + (q - 68), smem); continue; }
            else if (q < 112) {
              q -= 104;
              const int b = xcd;
              A = p->XTc + (size_t)b * 256 * 256; lda = 256; Bt = p->CS256; ldb = 256; K = 256;
              m0 = (q & 1) * 128; n0 = ((q >> 1) & 3) * 128; e.kind = EK_DFT; e.i0 = NLAT + b * 256; e.i1 = 255; e.i2 = 8; e.i3 = 0;
            } else if (q < 116) { dft_nyquist_item(p, xcd, q - 112); continue; }
            else { wconv_item(p, l + 1, xcd * (NW_ITEMS / 8) + (q - 116), smem); continue; }
          } else if (s == 3) {
            if (q < 54) {
              A = p->hp + HQ; lda = HPS; Bt = p->WuqT + (size_t)(l & 1) * 384 * 256; ldb = 256; K = 256;
              m0 = (xcd * 18 + q / 3) * 128; n0 = (q % 3) * 128; e.kind = EK_Q;
            } else if ((q -= 54) < 72) {
              A = p->hp + HKV; lda = HPS; Bt = p->WukvT + (size_t)(l & 1) * 512 * 128; ldb = 128; K = 128;
              m0 = (xcd * 18 + (q >> 2)) * 128; n0 = (q & 3) * 128; e.kind = EK_KV;
            } else if ((q -= 72) < 36) {
              A = p->convA; lda = 256; Bt = p->WpwT + (size_t)(l & 1) * 65536; ldb = 256; K = 256;
              m0 = (xcd * 18 + (q >> 1)) * 128; n0 = (q & 1) * 128;
              e.kind = EK_GATED; e.f0 = p->b_pw + l * 256; e.i0 = HGATE + 256; e.i1 = 256;
            } else if ((q -= 36) < 72) {
              const int chunk = xcd * 18 + (q >> 2), g = q & 3;
              A = p->Wsb + (size_t)(l & 1) * 65536 + (size_t)g * 16384; lda = 128;
              Bt = p->vnT + ((size_t)chunk * 256 + g * 64) * 128; ldb = 128; K = 128;
              m0 = 0; n0 = 0; nt4 = 0; e.kind = EK_SGU; e.f0 = p->b_s + (size_t)(l * 4 + g) * 128; e.i0 = chunk * 128; e.i1 = g;
            } else {
              q -= 72;
              A = p->T; lda = 512; Bt = p->WfT + (size_t)(l & 1) * 256 * 512; ldb = 512; K = 512;
              m0 = (xcd * 18 + (q >> 1)) * 128; n0 = (q & 1) * 128;
              e.kind = EK_GATED; e.f0 = p->b_fourier + l * 256; e.i0 = HGATE + 512; e.i1 = 512;
            }
          } else if (s == 4) {
            isattn = 1; A = nullptr; Bt = nullptr; lda = ldb = K = m0 = n0 = 0;
            it = (q < 64) ? (xcd * 64 + q) : (512 + xcd * 8 + (q - 64));
          } else {
            int mt, nt;
            if (l == 3) { mt = xcd * 16 + (q / 64) * 8 + (q & 7); nt = (q >> 3) & 7; }
            else { mt = xcd * 18 + (q / 72) * 9 + q % 9; nt = (q / 9) & 7; }
            A = p->y; lda = 1024; Bt = p->WoutT + (size_t)(l & 1) * 1024 * 1024; ldb = 1024; K = 1024;
            m0 = mt * 128; n0 = nt * 128; e.kind = EK_OUT;
          }
          if (isattn) attn_item(p, it, smem);
          else if (nt4) gemm_bd(A, lda, Bt, K, m0, n0, p, e, (bf16_t*)smem);
          else gemm_tile<2>(A, lda, Bt, ldb, K, m0, n0, p, e, (bf16_t*)smem);
        }
      }
    }
    if (COOP) {
      if ((ph2 & 1) && ph + 1 < ph_hi) xcd_barrier(xb);
      if (!(ph2 & 1)) for (int k = 0; k < PROBE_SYNCS; ++k) xcd_barrier(xb);
    }
  }
}


extern "C" void kernel_launch(void* const* d_in, const int* in_sizes, int n_in, void* d_out, int out_size, void* d_ws,
                              size_t ws_size, hipStream_t stream) {
  Params p{};
  const float** pp = (const float**)&p;
  for (int i = 0; i < 26; ++i) pp[i] = (const float*)d_in[i];
  p.out = (float*)d_out;
  char* w = (char*)d_ws;
  size_t off = 0;
  auto take = [&](size_t bytes) { char* r = w + off; off += (bytes + 255) & ~(size_t)255; return r; };
  p.xc = (float*)take((size_t)2048 * 1024 * 4);
  p.mod = (float*)take((size_t)4 * 9 * 3072 * 4);
  p.rstdq = (float*)take((size_t)NROW * 4);
  p.rstdkv = (float*)take((size_t)NROW * 4);
  p.h = (bf16_t*)take((size_t)NROW * 1024 * 2);
  p.convA = p.h;
  p.vnT = p.h + (size_t)NROW * 256;
  p.T = p.h + (size_t)NROW * 512;
  p.y = (bf16_t*)take((size_t)NROW * 1024 * 2);
  p.hp = (bf16_t*)take((size_t)NROW * HPS * 2);
  p.XT = (bf16_t*)take((size_t)8 * 256 * 2048 * 2);
  p.XTc = (bf16_t*)take((size_t)8 * 256 * 256 * 2);
  p.q = (bf16_t*)take((size_t)8 * 4 * 2048 * 96 * 2);
  p.qc = (bf16_t*)take((size_t)8 * 4 * 256 * 96 * 2);
  p.kall = (bf16_t*)take((size_t)8 * 4 * 2304 * 96 * 2);
  p.vT = (bf16_t*)take((size_t)8 * 4 * 64 * 2304 * 2);
  p.WinT = (bf16_t*)take((size_t)NIN * 1024 * 2);
  p.WoutT = (bf16_t*)take((size_t)2 * 1024 * 1024 * 2);
  p.WuqT = (bf16_t*)take((size_t)2 * 384 * 256 * 2);
  p.WukvT = (bf16_t*)take((size_t)2 * 512 * 128 * 2);
  p.WpwT = (bf16_t*)take((size_t)2 * 256 * 256 * 2);
  p.WfT = (bf16_t*)take((size_t)2 * 256 * 512 * 2);
  p.Wsb = (bf16_t*)take((size_t)2 * 4 * 128 * 128 * 2);
  p.CS2048 = (bf16_t*)take((size_t)2048 * 2048 * 2);
  p.CS256 = (bf16_t*)take((size_t)512 * 256 * 2);
  p.bar = (unsigned*)take((size_t)(XCD_BAR_WORDS + 2 * N_PHASES * 8 * 16) * 4);
  if (off > ws_size) { fprintf(stderr, "kernel_launch: workspace too small: need %zu have %zu\n", off, ws_size); return; }

#if MK_COOP
  static int grid_blocks = 0;
  if (!grid_blocks) {
    int dev = 0, cus = 0, per_cu = 0;
    hipGetDevice(&dev);
    hipDeviceGetAttribute(&cus, hipDeviceAttributeMultiprocessorCount, dev);
    hipOccupancyMaxActiveBlocksPerMultiprocessor(&per_cu, mega<true>, 256, 0);
    if (per_cu > 2) per_cu = 2;
    if (per_cu < 1) per_cu = 1;
    grid_blocks = cus * per_cu;
  }
  hipMemsetAsync(p.bar, 0, (size_t)(XCD_BAR_WORDS + 2 * N_PHASES * 8 * 16) * 4, stream);
  int lo = 0, hi = N_PHASES;
  void* args[] = {&p, &lo, &hi};
  hipError_t e = hipLaunchCooperativeKernel((void*)mega<true>, dim3(grid_blocks), dim3(256), args, 0, stream);
  if (e != hipSuccess) fprintf(stderr, "cooperative launch failed: %s (grid %d)\n", hipGetErrorString(e), grid_blocks);
#else
  for (int ph = 0; ph < N_PHASES; ++ph) hipLaunchKernelGGL(mega<false>, dim3(512), dim3(256), 0, stream, p, ph, ph + 1);
#endif
}
```

```cpp
#include <hip/hip_runtime.h>
#include <hip/hip_cooperative_groups.h>
#include <cstdio>
namespace cg = cooperative_groups;

typedef unsigned short bf16_t;
using bf16x8 = __attribute__((ext_vector_type(8))) short;
using f32x4 = __attribute__((ext_vector_type(4))) float;
using u32x4 = __attribute__((ext_vector_type(4))) unsigned int;

#ifndef MK_COOP
#define MK_COOP 1
#endif

constexpr int NROW = 18432;
constexpr int NLAT = 16384;
constexpr int HPS = 2560;
constexpr int HQ = 0, HKV = 256, HCONV = 384, HSGU = 896, HGATE = 1408, HROPE = 2432;
constexpr int NIN = 2816;
constexpr int LSTR = 80;
constexpr int KSTR = 112;

struct Params {
  const float *x, *c, *ctx, *c_ctx, *w_ada, *b_ada, *norm_g, *w_in, *q_norm_g, *w_uq, *kv_norm_g, *w_ukv,
      *conv_w, *conv_b, *conv_ln_g, *conv_ln_b, *w_pw, *b_pw, *w_fourier, *b_fourier,
      *sgu_ln_g, *sgu_ln_b, *w_s, *b_s, *w_out, *final_g;
  float* out;
  float *xc, *mod, *rstdq, *rstdkv;
  bf16_t *h, *convA, *vnT, *T;
  bf16_t *y, *hp, *XT, *XTc, *q, *qc, *kall, *vT;
  bf16_t *WinT, *WoutT, *WuqT, *WukvT, *WpwT, *WfT, *Wsb, *CS2048, *CS256;
  unsigned* bar;
};

typedef const __attribute__((address_space(4))) Params* KP;
__device__ __forceinline__ KP kparams() {
  KP pp = (KP)__builtin_amdgcn_kernarg_segment_ptr();
  asm volatile("" : "+s"(pp));
  return pp;
}

__device__ __forceinline__ int tid_opaque() {
  int t = threadIdx.x;
  asm volatile("" : "+v"(t));
  return t;
}
__device__ __forceinline__ bf16_t f2bf(float f) {
  unsigned u = __float_as_uint(f);
  u += 0x7fffu + ((u >> 16) & 1u);
  return (bf16_t)(u >> 16);
}
__device__ __forceinline__ float bf2f(bf16_t h) { return __uint_as_float(((unsigned)h) << 16); }
typedef __bf16 bf16x2_t __attribute__((ext_vector_type(2)));
typedef float f32x2_t __attribute__((ext_vector_type(2)));
__device__ __forceinline__ unsigned pack2(float a, float b) {
  const f32x2_t v = {a, b};
  return __builtin_bit_cast(unsigned, __builtin_convertvector(v, bf16x2_t));
}
__device__ __forceinline__ float sigmoid_f(float x) { return __builtin_amdgcn_rcpf(1.f + __builtin_amdgcn_exp2f(-1.4426950408889634f * x)); }
__device__ __forceinline__ float silu_f(float x) { return x * sigmoid_f(x); }
__device__ __forceinline__ float quad16_max(float v) {
  auto r = __builtin_amdgcn_permlane16_swap(__float_as_uint(v), __float_as_uint(v), false, false);
  const float m = fmaxf(__uint_as_float(r[0]), __uint_as_float(r[1]));
  auto r2 = __builtin_amdgcn_permlane32_swap(__float_as_uint(m), __float_as_uint(m), false, false);
  return fmaxf(__uint_as_float(r2[0]), __uint_as_float(r2[1]));
}
__device__ __forceinline__ float quad16_sum(float v) {
  auto r = __builtin_amdgcn_permlane16_swap(__float_as_uint(v), __float_as_uint(v), false, false);
  const float m = __uint_as_float(r[0]) + __uint_as_float(r[1]);
  auto r2 = __builtin_amdgcn_permlane32_swap(__float_as_uint(m), __float_as_uint(m), false, false);
  return __uint_as_float(r2[0]) + __uint_as_float(r2[1]);
}
template <int CTRL>
__device__ __forceinline__ float dpp_mov(float v) {
  return __uint_as_float((unsigned)__builtin_amdgcn_update_dpp(0, (int)__float_as_uint(v), CTRL, 0xf, 0xf, true));
}
__device__ __forceinline__ float wave_sum(float v) {
  v += dpp_mov<0xB1>(v);
  v += dpp_mov<0x4E>(v);
  v += dpp_mov<0x124>(v);
  v += dpp_mov<0x128>(v);
  return quad16_sum(v);
}
__device__ __forceinline__ const float* xsrc_row(KP p, int l, int row) {
  if (row < NLAT) return (l == 0 ? p->x : (const float*)p->out) + (size_t)row * 1024;
  return (l == 0 ? p->ctx : (const float*)p->xc) + (size_t)(row - NLAT) * 1024;
}
__device__ __forceinline__ float* xdst_row(KP p, int row) {
  return row < NLAT ? p->out + (size_t)row * 1024 : p->xc + (size_t)(row - NLAT) * 1024;
}
__device__ __forceinline__ float rope_inv(int f) {
  const float t[8] = {1.f, 0.316227766f, 0.1f, 0.0316227766f, 0.01f, 0.00316227766f, 0.001f, 0.000316227766f};
  float r = t[0];
#pragma unroll
  for (int i = 1; i < 8; ++i) r = (f == i) ? t[i] : r;
  return r;
}

struct EpiIn {
  bf16_t *hp, *XT, *XTc;
  __device__ __forceinline__ void operator()(int row0, int col, f32x4 v) const {
    if (col < HPS) {
#pragma unroll
      for (int r = 0; r < 4; ++r) hp[(size_t)(row0 + r) * HPS + col] = f2bf(v[r]);
    } else {
      const int ch = col - HPS;
      bf16_t* dst;
      if (row0 < NLAT) { const int b = row0 >> 11, s = row0 & 2047; dst = XT + ((size_t)(b * 256 + ch) * 2048 + s); }
      else { const int rr = row0 - NLAT; const int b = rr >> 8, t = rr & 255; dst = XTc + ((size_t)(b * 256 + ch) * 256 + t); }
      uint2 u; u.x = pack2(v[0], v[1]); u.y = pack2(v[2], v[3]);
      *(uint2*)dst = u;
    }
  }
};
struct EpiQ {
  bf16_t *q, *qc; const float* rstd;
  __device__ __forceinline__ void operator()(int row0, int col, f32x4 v) const {
    const int h = col / 96, d = col - h * 96;
#pragma unroll
    for (int r = 0; r < 4; ++r) {
      const int row = row0 + r;
      const float val = v[r] * rstd[row];
      if (row < NLAT) { const int b = row >> 11, s = row & 2047; q[((size_t)(b * 4 + h) * 2048 + s) * 96 + d] = f2bf(val); }
      else { const int rr = row - NLAT; const int b = rr >> 8, t = rr & 255; qc[((size_t)(b * 4 + h) * 256 + t) * 96 + d] = f2bf(val); }
    }
  }
};
struct EpiKV {
  bf16_t *kall, *vT; const float* rstd;
  __device__ __forceinline__ void operator()(int row0, int col, f32x4 v) const {
    const int h = col >> 7, part = (col >> 6) & 1, d = col & 63;
    int b, pos;
    if (row0 < NLAT) { b = row0 >> 11; pos = row0 & 2047; } else { const int rr = row0 - NLAT; b = rr >> 8; pos = 2048 + (rr & 255); }
    float w[4];
#pragma unroll
    for (int r = 0; r < 4; ++r) w[r] = v[r] * rstd[row0 + r];
    if (part == 0) {
#pragma unroll
      for (int r = 0; r < 4; ++r) kall[((size_t)(b * 4 + h) * 2304 + pos + r) * 96 + d] = f2bf(w[r]);
    } else {
      uint2 u; u.x = pack2(w[0], w[1]); u.y = pack2(w[2], w[3]);
      *(uint2*)(vT + ((size_t)(b * 4 + h) * 64 + d) * 2304 + pos) = u;
    }
  }
};
struct EpiDFT {
  bf16_t* T; int rowbase, mask, shift, mirror;
  __device__ __forceinline__ void operator()(int row0, int col, f32x4 v) const {
    const int tok = col & mask, half = col >> shift;
    uint2 u; u.x = pack2(v[0], v[1]); u.y = pack2(v[2], v[3]);
    *(uint2*)(T + (size_t)(rowbase + tok) * 512 + half * 256 + row0) = u;
    if (mirror && tok > 0) {
      uint2 w;
      if (half) { w.x = pack2(-v[0], -v[1]); w.y = pack2(-v[2], -v[3]); } else w = u;
      *(uint2*)(T + (size_t)(rowbase + 2048 - tok) * 512 + half * 256 + row0) = w;
    }
  }
};
struct EpiGated {
  bf16_t* y; const bf16_t* hp; const float* bias; int gcol0, ycol0;
  __device__ __forceinline__ void operator()(int row0, int col, f32x4 v) const {
    const float bb = bias[col];
#pragma unroll
    for (int r = 0; r < 4; ++r) {
      const int row = row0 + r;
      const float g = bf2f(hp[(size_t)row * HPS + gcol0 + col]);
      y[(size_t)row * 1024 + ycol0 + col] = f2bf((v[r] + bb) * silu_f(g));
    }
  }
};
struct EpiSGU {
  bf16_t* y; const bf16_t* hp; const float* bs; int rowbase, g;
  __device__ __forceinline__ void operator()(int row0, int col, f32x4 v) const {
#pragma unroll
    for (int r = 0; r < 4; ++r) {
      const int i = row0 + r, row = rowbase + i;
      const float u = bf2f(hp[(size_t)row * HPS + HSGU + g * 64 + col]);
      const float gt = bf2f(hp[(size_t)row * HPS + HGATE + 768 + g * 64 + col]);
      y[(size_t)row * 1024 + 768 + g * 64 + col] = f2bf((v[r] + bs[i]) * u * silu_f(gt));
    }
  }
};
struct EpiOut {
  KP p; int l;
  __device__ __forceinline__ void operator()(int row0, int col, f32x4 v) const {
    const int mr = row0 < NLAT ? (row0 >> 11) : 8;
    const float gm = p->mod[(size_t)(l * 9 + mr) * 3072 + 2048 + col];
#pragma unroll
    for (int r = 0; r < 4; ++r) {
      const int row = row0 + r;
      const float xo = xsrc_row(p, l, row)[col];
      xdst_row(p, row)[col] = xo + gm * v[r];
    }
  }
};


enum { EK_IN = 0, EK_Q, EK_KV, EK_DFT, EK_GATED, EK_OUT, EK_SGU };
struct EpiAny {
  int kind, l, i0, i1, i2, i3;
  const float* f0;
};

template <int NT>
__device__ __forceinline__ void gemm_tile(const bf16_t* __restrict__ A, int lda, const bf16_t* __restrict__ Bt, int ldb,
                                          int K, int m0, int n0, KP p, const EpiAny& e, bf16_t* smem) {
  bf16_t* sA = smem;
  bf16_t* sB = smem + 128 * LSTR;
  const int tid = tid_opaque(), lane = tid & 63, wid = tid >> 6, wm = wid >> 1, wn = wid & 1;
  const int lr = tid >> 3, lc = (tid & 7) * 8;
  const bf16_t* Ap = A + (size_t)(m0 + lr) * lda + lc;
  const bf16_t* Bp = Bt + (size_t)(n0 + lr) * ldb + lc;
  u32x4 ra[2][4], rb[2][NT];
  f32x4 acc[4][NT];
#pragma unroll
  for (int i = 0; i < 4; ++i)
#pragma unroll
    for (int j = 0; j < NT; ++j) acc[i][j] = f32x4{0.f, 0.f, 0.f, 0.f};
  const int nk = K >> 6;
#pragma unroll
  for (int st = 0; st < 2; ++st) {
#pragma unroll
    for (int i = 0; i < 4; ++i) ra[st][i] = *(const u32x4*)(Ap + (size_t)i * 32 * lda + st * 64);
#pragma unroll
    for (int i = 0; i < NT; ++i) rb[st][i] = *(const u32x4*)(Bp + (size_t)i * 32 * ldb + st * 64);
  }
  const int l15 = lane & 15, g4 = lane >> 4;
  for (int kt = 0; kt < nk; kt += 2) {
#pragma unroll
    for (int st = 0; st < 2; ++st) {
      __syncthreads();
#pragma unroll
      for (int i = 0; i < 4; ++i) *(u32x4*)(sA + (lr + i * 32) * LSTR + lc) = ra[st][i];
#pragma unroll
      for (int i = 0; i < NT; ++i) *(u32x4*)(sB + (lr + i * 32) * LSTR + lc) = rb[st][i];
      __syncthreads();
      if (kt + st + 2 < nk) {
        const int ko = (kt + st + 2) * 64;
#pragma unroll
        for (int i = 0; i < 4; ++i) ra[st][i] = *(const u32x4*)(Ap + (size_t)i * 32 * lda + ko);
#pragma unroll
        for (int i = 0; i < NT; ++i) rb[st][i] = *(const u32x4*)(Bp + (size_t)i * 32 * ldb + ko);
      }
#pragma unroll
      for (int ks = 0; ks < 2; ++ks) {
        bf16x8 af[4], bfr[NT];
#pragma unroll
        for (int i = 0; i < 4; ++i) af[i] = *(const bf16x8*)(sA + (wm * 64 + i * 16 + l15) * LSTR + ks * 32 + g4 * 8);
#pragma unroll
        for (int j = 0; j < NT; ++j) bfr[j] = *(const bf16x8*)(sB + (wn * (NT * 16) + j * 16 + l15) * LSTR + ks * 32 + g4 * 8);
#pragma unroll
        for (int i = 0; i < 4; ++i)
#pragma unroll
          for (int j = 0; j < NT; ++j) acc[i][j] = __builtin_amdgcn_mfma_f32_16x16x32_bf16(af[i], bfr[j], acc[i][j], 0, 0, 0);
      }
    }
  }
  const int rbase = m0 + wm * 64 + g4 * 4, cbase = n0 + wn * (NT * 16) + l15;
#define EPI_LOOP(EXPR)                                   \
  _Pragma("unroll") for (int i = 0; i < 4; ++i)          \
  _Pragma("unroll") for (int j = 0; j < NT; ++j) {       \
    const int row0 = rbase + i * 16, col = cbase + j * 16; \
    const f32x4 v = acc[i][j];                           \
    EXPR;                                                \
  }
  if constexpr (NT == 2) {
    EpiSGU ep{p->y, p->hp, e.f0, e.i0, e.i1};
    EPI_LOOP(ep(row0, col, v));
  } else {
    switch (e.kind) {
      case EK_IN: { EpiIn ep{p->hp, p->XT, p->XTc}; EPI_LOOP(ep(row0, col, v)); } break;
      case EK_Q: { EpiQ ep{p->q, p->qc, p->rstdq}; EPI_LOOP(ep(row0, col, v)); } break;
      case EK_KV: { EpiKV ep{p->kall, p->vT, p->rstdkv}; EPI_LOOP(ep(row0, col, v)); } break;
      case EK_DFT: { EpiDFT ep{p->T, e.i0, e.i1, e.i2, e.i3}; EPI_LOOP(ep(row0, col, v)); } break;
      case EK_GATED: { EpiGated ep{p->y, p->hp, e.f0, e.i0, e.i1}; EPI_LOOP(ep(row0, col, v)); } break;
      default: { EpiOut ep{p, e.l}; EPI_LOOP(ep(row0, col, v)); } break;
    }
  }
#undef EPI_LOOP
}

__device__ __forceinline__ size_t frag_off(int n, int k, int K) {
  return ((size_t)(n >> 4) * (K >> 5) + (k >> 5)) * 512 + ((((k & 31) >> 3) * 16) + (n & 15)) * 8 + (k & 7);
}

__device__ __forceinline__ void gemm_bd(const bf16_t* __restrict__ A, int lda, const bf16_t* __restrict__ Bf, int K, int m0, int n0,
                                        KP p, const EpiAny& e, bf16_t* smem) {
  const int tid = tid_opaque(), lane = tid & 63, wn = tid >> 6;
  const int lr = tid >> 3, lc = (tid & 7) * 8;
  const int l15 = lane & 15, g4 = lane >> 4;
  const bf16_t* Ap = A + (size_t)(m0 + lr) * lda + lc;
  const size_t jstr = (size_t)(K >> 5) * 512;
  const bf16_t* Bp = Bf + (size_t)((n0 >> 4) + wn * 2) * jstr + lane * 8;
  bf16_t* sA0 = smem;
  bf16_t* sA1 = smem + 128 * LSTR;
  u32x4 ra[4], b0[2][2], b1[2][2];
  f32x4 acc[8][2];
#pragma unroll
  for (int i = 0; i < 8; ++i)
#pragma unroll
    for (int j = 0; j < 2; ++j) acc[i][j] = f32x4{0.f, 0.f, 0.f, 0.f};
  const int nk = K >> 6;
#pragma unroll
  for (int i = 0; i < 4; ++i) ra[i] = *(const u32x4*)(Ap + (size_t)i * 32 * lda);
  __syncthreads();
#pragma unroll
  for (int i = 0; i < 4; ++i) *(u32x4*)(sA0 + (lr + i * 32) * LSTR + lc) = ra[i];
  __builtin_amdgcn_sched_barrier(0);
#pragma unroll
  for (int i = 0; i < 4; ++i) ra[i] = *(const u32x4*)(Ap + (size_t)i * 32 * lda + 64);
#pragma unroll
  for (int j = 0; j < 2; ++j)
#pragma unroll
    for (int ks = 0; ks < 2; ++ks) b0[j][ks] = *(const u32x4*)(Bp + j * jstr + ks * 512);
  __builtin_amdgcn_sched_barrier(0);
  __syncthreads();
#define GBD_STEP(SCUR, SNEXT, BC, BN, KT)                                                                   \
  {                                                                                                         \
    const int k1 = ((KT) + 1 < nk) ? (KT) + 1 : nk - 1;         \
    const int k2 = ((KT) + 2 < nk) ? (KT) + 2 : nk - 1;                                                     \
    _Pragma("unroll") for (int i = 0; i < 4; ++i) *(u32x4*)(SNEXT + (lr + i * 32) * LSTR + lc) = ra[i];     \
      \
    bf16x8 af[2][8];                                                                                        \
    _Pragma("unroll") for (int ks = 0; ks < 2; ++ks)                                                        \
    _Pragma("unroll") for (int i = 0; i < 8; ++i)                                                           \
      af[ks][i] = *(const bf16x8*)(SCUR + (i * 16 + l15) * LSTR + ks * 32 + g4 * 8);                        \
    __builtin_amdgcn_sched_barrier(0);                                                                      \
    _Pragma("unroll") for (int i = 0; i < 4; ++i)                                                           \
      ra[i] = *(const u32x4*)(Ap + (size_t)i * 32 * lda + k2 * 64);                                         \
    _Pragma("unroll") for (int j = 0; j < 2; ++j)                                                           \
    _Pragma("unroll") for (int ks = 0; ks < 2; ++ks)                                                        \
      BN[j][ks] = *(const u32x4*)(Bp + j * jstr + (size_t)(k1 * 2 + ks) * 512);                             \
    __builtin_amdgcn_sched_barrier(0);                                                                      \
    __builtin_amdgcn_s_setprio(1);                                                                          \
    _Pragma("unroll") for (int ks = 0; ks < 2; ++ks)                                                        \
    _Pragma("unroll") for (int i = 0; i < 8; ++i)                                                           \
    _Pragma("unroll") for (int j = 0; j < 2; ++j)                                                           \
      acc[i][j] = __builtin_amdgcn_mfma_f32_16x16x32_bf16(af[ks][i], __builtin_bit_cast(bf16x8, BC[j][ks]), acc[i][j], 0, 0, 0); \
    __builtin_amdgcn_s_setprio(0);                                                                          \
    __syncthreads();                                                                                        \
  }
  for (int kt = 0; kt < nk; kt += 2) {
    GBD_STEP(sA0, sA1, b0, b1, kt)
    GBD_STEP(sA1, sA0, b1, b0, kt + 1)
  }
#undef GBD_STEP
  if (e.kind == EK_OUT || e.kind == EK_GATED || (e.kind == EK_IN && n0 < HPS)) {
    float* stg = (float*)smem;
    const int rr = tid >> 2, c0 = (tid & 3) * 32;
#pragma unroll
    for (int half = 0; half < 2; ++half) {
      if (half) __syncthreads();
#pragma unroll
      for (int ii = 0; ii < 4; ++ii)
#pragma unroll
        for (int j = 0; j < 2; ++j)
#pragma unroll
          for (int r = 0; r < 4; ++r) stg[(ii * 16 + g4 * 4 + r) * 132 + wn * 32 + j * 16 + l15] = acc[half * 4 + ii][j][r];
      __syncthreads();
      const int row = m0 + half * 64 + rr, col = n0 + c0;
      float4 v[8];
#pragma unroll
      for (int k = 0; k < 8; ++k) v[k] = *(const float4*)(stg + rr * 132 + c0 + k * 4);
      if (e.kind == EK_OUT) {
        const int mr = row < NLAT ? (row >> 11) : 8;
        const float* gm = p->mod + (size_t)(e.l * 9 + mr) * 3072 + 2048 + col;
        const float* xs = xsrc_row(p, e.l, row) + col;
        float* xd = xdst_row(p, row) + col;
#pragma unroll
        for (int k = 0; k < 8; ++k) {
          const float4 xo = *(const float4*)(xs + k * 4);
          const float4 g = *(const float4*)(gm + k * 4);
          float4 o;
          o.x = xo.x + g.x * v[k].x; o.y = xo.y + g.y * v[k].y; o.z = xo.z + g.z * v[k].z; o.w = xo.w + g.w * v[k].w;
          *(float4*)(xd + k * 4) = o;
        }
      } else if (e.kind == EK_IN) {
        bf16_t* dst = p->hp + (size_t)row * HPS + col;
#pragma unroll
        for (int k = 0; k < 4; ++k) {
          u32x4 u;
          u[0] = pack2(v[2 * k].x, v[2 * k].y); u[1] = pack2(v[2 * k].z, v[2 * k].w);
          u[2] = pack2(v[2 * k + 1].x, v[2 * k + 1].y); u[3] = pack2(v[2 * k + 1].z, v[2 * k + 1].w);
          *(u32x4*)(dst + k * 8) = u;
        }
      } else {
        const bf16_t* gp = p->hp + (size_t)row * HPS + e.i0 + col;
        const float* bp = e.f0 + col;
        bf16_t* dst = p->y + (size_t)row * 1024 + e.i1 + col;
#pragma unroll
        for (int k = 0; k < 4; ++k) {
          const u32x4 gu = *(const u32x4*)(gp + k * 8);
          const float4 ba = *(const float4*)(bp + k * 8), bb = *(const float4*)(bp + k * 8 + 4);
          u32x4 u;
          u[0] = pack2((v[2 * k].x + ba.x) * silu_f(bf2f((bf16_t)(gu[0] & 0xffff))), (v[2 * k].y + ba.y) * silu_f(bf2f((bf16_t)(gu[0] >> 16))));
          u[1] = pack2((v[2 * k].z + ba.z) * silu_f(bf2f((bf16_t)(gu[1] & 0xffff))), (v[2 * k].w + ba.w) * silu_f(bf2f((bf16_t)(gu[1] >> 16))));
          u[2] = pack2((v[2 * k + 1].x + bb.x) * silu_f(bf2f((bf16_t)(gu[2] & 0xffff))), (v[2 * k + 1].y + bb.y) * silu_f(bf2f((bf16_t)(gu[2] >> 16))));
          u[3] = pack2((v[2 * k + 1].z + bb.z) * silu_f(bf2f((bf16_t)(gu[3] & 0xffff))), (v[2 * k + 1].w + bb.w) * silu_f(bf2f((bf16_t)(gu[3] >> 16))));
          *(u32x4*)(dst + k * 8) = u;
        }
      }
    }
    return;
  }
  const int rbase = m0 + g4 * 4, cbase = n0 + wn * 32 + l15;
#define EPI_LOOP(EXPR)                                   \
  _Pragma("unroll") for (int i = 0; i < 8; ++i)          \
  _Pragma("unroll") for (int j = 0; j < 2; ++j) {        \
    const int row0 = rbase + i * 16, col = cbase + j * 16; \
    const f32x4 v = acc[i][j];                           \
    EXPR;                                                \
  }
  switch (e.kind) {
    case EK_IN: { EpiIn ep{p->hp, p->XT, p->XTc}; EPI_LOOP(ep(row0, col, v)); } break;
    case EK_Q: { EpiQ ep{p->q, p->qc, p->rstdq}; EPI_LOOP(ep(row0, col, v)); } break;
    case EK_KV: { EpiKV ep{p->kall, p->vT, p->rstdkv}; EPI_LOOP(ep(row0, col, v)); } break;
    case EK_DFT: { EpiDFT ep{p->T, e.i0, e.i1, e.i2, e.i3}; EPI_LOOP(ep(row0, col, v)); } break;
    case EK_GATED: { EpiGated ep{p->y, p->hp, e.f0, e.i0, e.i1}; EPI_LOOP(ep(row0, col, v)); } break;
    default: { EpiOut ep{p, e.l}; EPI_LOOP(ep(row0, col, v)); } break;
  }
#undef EPI_LOOP
}

__device__ __forceinline__ void tconv32(const float* __restrict__ src, int src_ld, int k0, int ns0, bf16_t* dst, int dst_ld,
                                        int nd0, const float* kscale, float scale, float* sm) {
  const int tid = tid_opaque();
  __syncthreads();
  if (ns0 >= 0) {
    const int n = tid & 31, kk = tid >> 5;
#pragma unroll
    for (int i = 0; i < 8; ++i) {
      const int k = kk + 8 * i;
      float v = src[(size_t)(k0 + k) * src_ld + ns0 + n] * scale;
      if (kscale) v *= kscale[k0 + k];
      sm[k * 33 + n] = v;
    }
  }
  __syncthreads();
  const int n2 = tid >> 3, kc = (tid & 7) * 8;
  uint4 u = make_uint4(0, 0, 0, 0);
  if (ns0 >= 0) {
    u.x = pack2(sm[(kc + 0) * 33 + n2], sm[(kc + 1) * 33 + n2]);
    u.y = pack2(sm[(kc + 2) * 33 + n2], sm[(kc + 3) * 33 + n2]);
    u.z = pack2(sm[(kc + 4) * 33 + n2], sm[(kc + 5) * 33 + n2]);
    u.w = pack2(sm[(kc + 6) * 33 + n2], sm[(kc + 7) * 33 + n2]);
  }
  *(uint4*)(dst + frag_off(nd0 + n2, k0 + kc, dst_ld)) = u;
}

__device__ __forceinline__ void tconv32x4(const float* __restrict__ src, int src_ld, int k0, int ns0, bf16_t* dst, int dst_ld,
                                          int nd0, float* sm) {
  const int tid = tid_opaque();
  const int n = tid & 31, kk = tid >> 5;
  float v[4][8];
  if (ns0 >= 0) {
#pragma unroll
    for (int t = 0; t < 4; ++t)
#pragma unroll
      for (int i = 0; i < 8; ++i) v[t][i] = src[(size_t)(k0 + t * 64 + kk + 8 * i) * src_ld + ns0 + n];
  } else {
#pragma unroll
    for (int t = 0; t < 4; ++t)
#pragma unroll
      for (int i = 0; i < 8; ++i) v[t][i] = 0.f;
  }
  const int n2 = tid >> 3, kc = (tid & 7) * 8;
#pragma unroll
  for (int t = 0; t < 4; ++t) {
    __syncthreads();
#pragma unroll
    for (int i = 0; i < 8; ++i) sm[(kk + 8 * i) * 33 + n] = v[t][i];
    __syncthreads();
    uint4 u;
    u.x = pack2(sm[(kc + 0) * 33 + n2], sm[(kc + 1) * 33 + n2]);
    u.y = pack2(sm[(kc + 2) * 33 + n2], sm[(kc + 3) * 33 + n2]);
    u.z = pack2(sm[(kc + 4) * 33 + n2], sm[(kc + 5) * 33 + n2]);
    u.w = pack2(sm[(kc + 6) * 33 + n2], sm[(kc + 7) * 33 + n2]);
    *(uint4*)(dst + frag_off(nd0 + n2, k0 + t * 64 + kc, dst_ld)) = u;
  }
}
constexpr int NW_ITEMS = 88 * 4 + 32 * 4 + 12 * 4 + 16 * 2 + 8 * 4 + 512 + 32;
__device__ void wconv_item(KP p, int l, int i, char* smem) {
  const int tid = tid_opaque();
  const int n_win = 88 * 4, n_wout = 32 * 4, n_wuq = 12 * 4, n_wukv = 16 * 2, n_wpw = 8 * 4, n_wf = 512;
  const int par = l & 1;
  float* sm = (float*)smem;
  if (i < n_win) {
    const int d = i >> 2, kq = i & 3;
    int s;
    if (d < 12) s = d; else if (d < 28) s = d + 1; else if (d < 76) s = d + 9; else if (d == 76) s = 12; else if (d < 80) s = -1; else s = d - 51;
    tconv32x4(p->w_in + (size_t)l * 1024 * 2720, 2720, kq * 256, s < 0 ? -1 : s * 32, p->WinT, 1024, d * 32, sm);
    return;
  }
  i -= n_win;
  if (i < n_wout) {
    const int d = i >> 2, kq = i & 3;
    tconv32x4(p->w_out + (size_t)l * 1024 * 1024, 1024, kq * 256, d * 32, p->WoutT + (size_t)par * 1024 * 1024, 1024, d * 32, sm);
    return;
  }
  i -= n_wout;
  if (i < n_wuq) {
    const int d = i >> 2, kt = i & 3;
    tconv32(p->w_uq + (size_t)l * 256 * 384, 384, kt * 64, d * 32, p->WuqT + (size_t)par * 384 * 256, 256, d * 32, p->q_norm_g + l * 256,
            0.10206207261596577f * 1.4426950408889634f, sm);
    return;
  }
  i -= n_wuq;
  if (i < n_wukv) {
    const int d = i >> 1, kt = i & 1;
    tconv32(p->w_ukv + (size_t)l * 128 * 512, 512, kt * 64, d * 32, p->WukvT + (size_t)par * 512 * 128, 128, d * 32, p->kv_norm_g + l * 128, 1.f, sm);
    return;
  }
  i -= n_wukv;
  if (i < n_wpw) {
    const int d = i >> 2, kt = i & 3;
    tconv32(p->w_pw + (size_t)l * 256 * 256, 256, kt * 64, d * 32, p->WpwT + (size_t)par * 65536, 256, d * 32, nullptr, 1.f, sm);
    return;
  }
  i -= n_wpw;
  if (i < n_wf) {
    float* tab = (float*)smem;
    __syncthreads();
    if (tid < 64) { tab[tid] = cospif((float)tid * (1.f / 32.f)); tab[64 + tid] = sinpif((float)tid * (1.f / 32.f)); }
    __syncthreads();
    const int o = i * 256 + tid;
    const int n = o & 255, kk = o >> 8;
    const int half = kk >> 8, gc = kk & 255, g = gc >> 6, c = gc & 63;
    const float* wf = p->w_fourier + (size_t)l * 65536 + (size_t)(g * 64) * 256 + n;
    float acc = 0.f;
#pragma unroll 8
    for (int m = 0; m < 64; ++m) {
      const int j = (c * m) & 63;
      const float tv = half ? -tab[64 + j] : tab[j];
      acc += tv * wf[(size_t)m * 256];
    }
    p->WfT[(size_t)par * 256 * 512 + frag_off(n, kk, 512)] = f2bf(acc * 0.125f);
    return;
  }
  i -= n_wf;
  {
    const int o = (i * 256 + tid) * 8;
    const float* s = p->w_s + (size_t)l * 65536 + o;
    const float4 a = *(const float4*)s, b = *(const float4*)(s + 4);
    *(uint4*)(p->Wsb + (size_t)par * 65536 + o) = make_uint4(pack2(a.x, a.y), pack2(a.z, a.w), pack2(b.x, b.y), pack2(b.z, b.w));
  }
}

__device__ void phase0(KP p, char* smem) {
  const int tid = tid_opaque();
  const int n_dft = 2048, n_dft2 = 512, n_ada = 768;
  const int total = n_ada + n_dft + n_dft2 + NW_ITEMS;
  for (int it = blockIdx.x; it < total; it += gridDim.x) {
    if (it >= n_ada + n_dft + n_dft2) { wconv_item(p, 0, it - (n_ada + n_dft + n_dft2), smem); continue; }
    if (it < n_ada) {
      const int l = it / 192, nb = it % 192;
      float* sm_s = (float*)smem;
      float* red = sm_s + 9 * 1024;
      __syncthreads();
      for (int idx = tid; idx < 9216; idx += 256) {
        const int r = idx >> 10, k = idx & 1023;
        const float cv = r < 8 ? p->c[r * 1024 + k] : p->c_ctx[k];
        sm_s[idx] = silu_f(cv);
      }
      __syncthreads();
      const int col = tid & 15, ks = tid >> 4;
      const int n = nb * 16 + col;
      float acc[9];
#pragma unroll
      for (int r = 0; r < 9; ++r) acc[r] = 0.f;
      const float* wp = p->w_ada + ((size_t)l * 1024 + ks * 64) * 3072 + n;
#pragma unroll
      for (int hb = 0; hb < 2; ++hb) {
        float w[32];
#pragma unroll
        for (int kk = 0; kk < 32; ++kk) w[kk] = wp[(size_t)(hb * 32 + kk) * 3072];
#pragma unroll
        for (int kk = 0; kk < 32; ++kk) {
          const int k = ks * 64 + hb * 32 + kk;
#pragma unroll
          for (int r = 0; r < 9; ++r) acc[r] += sm_s[r * 1024 + k] * w[kk];
        }
      }
#pragma unroll
      for (int r = 0; r < 9; ++r) red[(ks * 16 + col) * 9 + r] = acc[r];
      __syncthreads();
      if (tid < 144) {
        const int r = tid >> 4, c2 = tid & 15;
        float s = 0.f;
        for (int k2 = 0; k2 < 16; ++k2) s += red[(k2 * 16 + c2) * 9 + r];
        const int n2 = nb * 16 + c2;
        p->mod[(size_t)(l * 9 + r) * 3072 + n2] = s + p->b_ada[l * 3072 + n2];
      }
    } else if (it < n_ada + n_dft) {
      const int m = it - n_ada;
      const int half = m >> 10, kp = m & 1023;
      const float sc = 0.02209708691207961f;
      unsigned w[4];
#pragma unroll
      for (int e = 0; e < 4; ++e) {
        float v2[2];
#pragma unroll
        for (int e2 = 0; e2 < 2; ++e2) {
          const int n = tid * 8 + e * 2 + e2;
          const int j = (kp * n) & 2047;
          const float a = (float)j * (1.f / 1024.f);
          v2[e2] = (half ? sinpif(a) : cospif(a)) * sc;
        }
        w[e] = pack2(v2[0], v2[1]);
      }
      *(uint4*)(p->CS2048 + frag_off(m, tid * 8, 2048)) = make_uint4(w[0], w[1], w[2], w[3]);
    } else {
      const int m = it - n_ada - n_dft;
      const int half = m >> 8, kp = m & 255;
      const int n = tid;
      const int j = (kp * n) & 255;
      const float a = (float)j * (1.f / 128.f);
      p->CS256[frag_off(m, n, 256)] = f2bf((half ? sinpif(a) : cospif(a)) * 0.0625f);
    }
  }
}

__device__ void phaseA(KP p, int l, char* smem) {
  const int tid = tid_opaque(), lane = tid & 63, wid = tid >> 6;
  for (int it = blockIdx.x; it < NROW / 8; it += gridDim.x) {
    const int row0 = it * 8 + wid * 2;
    float4 v[2][4];
    float ss[2];
#pragma unroll
    for (int rr = 0; rr < 2; ++rr) {
      const float* xr = xsrc_row(p, l, row0 + rr);
      ss[rr] = 0.f;
#pragma unroll
      for (int e = 0; e < 4; ++e) v[rr][e] = *(const float4*)(xr + e * 256 + lane * 4);
    }
    const int mr = row0 < NLAT ? (row0 >> 11) : 8;
    const float* md = p->mod + (size_t)(l * 9 + mr) * 3072;
    const float* ng = p->norm_g + l * 1024;
#pragma unroll
    for (int rr = 0; rr < 2; ++rr) {
#pragma unroll
      for (int e = 0; e < 4; ++e)
        ss[rr] += v[rr][e].x * v[rr][e].x + v[rr][e].y * v[rr][e].y + v[rr][e].z * v[rr][e].z + v[rr][e].w * v[rr][e].w;
      ss[rr] = wave_sum(ss[rr]);
    }
#pragma unroll
    for (int e = 0; e < 4; ++e) {
      const int k = e * 256 + lane * 4;
      const float4 g = *(const float4*)(ng + k);
      const float4 sh = *(const float4*)(md + k);
      const float4 sc = *(const float4*)(md + 1024 + k);
#pragma unroll
      for (int rr = 0; rr < 2; ++rr) {
        const float rstd = rsqrtf(ss[rr] * (1.f / 1024.f) + 1e-6f);
        uint2 u;
        u.x = pack2(v[rr][e].x * rstd * g.x * (1.f + sc.x) + sh.x, v[rr][e].y * rstd * g.y * (1.f + sc.y) + sh.y);
        u.y = pack2(v[rr][e].z * rstd * g.z * (1.f + sc.z) + sh.z, v[rr][e].w * rstd * g.w * (1.f + sc.w) + sh.w);
        *(uint2*)(p->h + (size_t)(row0 + rr) * 1024 + k) = u;
      }
    }
  }
}

__device__ void phaseC_rows(KP p, int l, int item, char* smem) {
  const int tid = tid_opaque(), lane = tid & 63, wid = tid >> 6;
  bf16_t* vt = (bf16_t*)smem;
  const int r0 = item * 64;
  __syncthreads();
  const float* lg = p->sgu_ln_g + l * 256;
  const float* lb = p->sgu_ln_b + l * 256;
  const float4 g4v = *(const float4*)(lg + lane * 4);
  const float4 b4v = *(const float4*)(lb + lane * 4);
  for (int rr = 0; rr < 16; ++rr) {
    const int tok = wid * 16 + rr;
    const int row = r0 + tok;
    const bf16_t* hr = p->hp + (size_t)row * HPS;
    {
      const uint2 u = *(const uint2*)(hr + HQ + lane * 4);
      const float a0 = bf2f(u.x & 0xffff), a1 = bf2f(u.x >> 16), a2 = bf2f(u.y & 0xffff), a3 = bf2f(u.y >> 16);
      const float ss = wave_sum(a0 * a0 + a1 * a1 + a2 * a2 + a3 * a3);
      if (lane == 0) p->rstdq[row] = rsqrtf(ss * (1.f / 256.f) + 1e-6f);
    }
    {
      const unsigned u = *(const unsigned*)(hr + HKV + lane * 2);
      const float a0 = bf2f(u & 0xffff), a1 = bf2f(u >> 16);
      const float ss = wave_sum(a0 * a0 + a1 * a1);
      if (lane == 0) p->rstdkv[row] = rsqrtf(ss * (1.f / 128.f) + 1e-6f);
    }
    {
      const uint2 u = *(const uint2*)(hr + HSGU + 256 + lane * 4);
      const float a0 = bf2f(u.x & 0xffff), a1 = bf2f(u.x >> 16), a2 = bf2f(u.y & 0xffff), a3 = bf2f(u.y >> 16);
      const float s1 = wave_sum(a0 + a1 + a2 + a3);
      const float mu = s1 * (1.f / 256.f);
      const float d0 = a0 - mu, d1 = a1 - mu, d2 = a2 - mu, d3 = a3 - mu;
      const float s2 = wave_sum(d0 * d0 + d1 * d1 + d2 * d2 + d3 * d3);
      const float rs = rsqrtf(s2 * (1.f / 256.f) + 1e-5f);
      vt[(lane * 4 + 0) * LSTR + tok] = f2bf(d0 * rs * g4v.x + b4v.x);
      vt[(lane * 4 + 1) * LSTR + tok] = f2bf(d1 * rs * g4v.y + b4v.y);
      vt[(lane * 4 + 2) * LSTR + tok] = f2bf(d2 * rs * g4v.z + b4v.z);
      vt[(lane * 4 + 3) * LSTR + tok] = f2bf(d3 * rs * g4v.w + b4v.w);
    }
    {
      const float own = (lane < 32) ? bf2f(hr[HROPE + lane]) : 0.f;
      const float par = __shfl_xor(own, 8);
      float outv = own;
      int b, pos;
      if (row < NLAT) {
        b = row >> 11; const int s = row & 2047; pos = s;
        const int axis = (lane >> 4) & 1, idx = lane & 15, f = idx & 7, isx2 = idx >> 3;
        const float ang = (float)(axis == 0 ? (s >> 6) : (s & 63)) * rope_inv(f);
        float sn, cs;
        sincosf(ang, &sn, &cs);
        outv = isx2 ? (par * sn + own * cs) : (own * cs - par * sn);
      } else { const int rr2 = row - NLAT; b = rr2 >> 8; pos = 2048 + (rr2 & 255); }
      if (lane < 32) {
        const bf16_t ov = f2bf(outv);
#pragma unroll
        for (int h = 0; h < 4; ++h) p->kall[((size_t)(b * 4 + h) * 2304 + pos) * 96 + 64 + lane] = ov;
      }
    }
  }
  __syncthreads();
  {
    const int chunk = r0 >> 7, toff = r0 & 127;
    bf16_t* dst = p->vnT + ((size_t)chunk * 256 + tid) * 128 + toff;
#pragma unroll
    for (int e = 0; e < 8; ++e) *(uint4*)(dst + e * 8) = *(const uint4*)(vt + tid * LSTR + e * 8);
  }
}

__device__ void phaseC_conv(KP p, int l, int item, char* smem) {
  const int tid = tid_opaque(), lane = tid & 63, wid = tid >> 6;
  bf16_t* glu = (bf16_t*)smem;
  float* part = (float*)(smem + 94 * 256 * 2);
  int rb, t0, slen;
  if (item < 256) { rb = (item >> 5) * 2048; t0 = (item & 31) * 64; slen = 2048; }
  else { const int i2 = item - 256; rb = NLAT + (i2 >> 2) * 256; t0 = (i2 & 3) * 64; slen = 256; }
  const int c = tid;
  __syncthreads();
#pragma unroll
  for (int half = 0; half < 2; ++half) {
    u32x4 av[6], gv[6];
#pragma unroll
    for (int i = 0; i < 6; ++i) {
      const int pi = tid + 256 * (half * 6 + i);
      const int r = pi >> 5, c8 = (pi & 31) * 8;
      const int tok = t0 - 15 + r;
      av[i] = u32x4{0u, 0u, 0u, 0u};
      gv[i] = u32x4{0u, 0u, 0u, 0u};
      if (pi < 3008 && tok >= 0 && tok < slen) {
        const bf16_t* hr = p->hp + (size_t)(rb + tok) * HPS + HCONV + c8;
        av[i] = *(const u32x4*)hr;
        gv[i] = *(const u32x4*)(hr + 256);
      }
    }
#pragma unroll
    for (int i = 0; i < 6; ++i) {
      const int pi = tid + 256 * (half * 6 + i);
      const int r = pi >> 5, c8 = (pi & 31) * 8;
      u32x4 o;
#pragma unroll
      for (int e = 0; e < 4; ++e) {
        const float a0 = bf2f((bf16_t)(av[i][e] & 0xffff)), a1 = bf2f((bf16_t)(av[i][e] >> 16));
        const float g0 = bf2f((bf16_t)(gv[i][e] & 0xffff)), g1 = bf2f((bf16_t)(gv[i][e] >> 16));
        o[e] = pack2(a0 * sigmoid_f(g0), a1 * sigmoid_f(g1));
      }
      if (pi < 3008) *(u32x4*)(glu + r * 256 + c8) = o;
    }
  }
  float w[31];
#pragma unroll
  for (int k = 0; k < 31; ++k) w[k] = p->conv_w[(size_t)(l * 31 + k) * 256 + c];
  const float cb = p->conv_b[l * 256 + c];
  const float lg = p->conv_ln_g[l * 256 + c], lb = p->conv_ln_b[l * 256 + c];
  __syncthreads();
  for (int blk = 0; blk < 8; ++blk) {
    const int tb = blk * 8, par = blk & 1;
    float g[38];
#pragma unroll
    for (int i = 0; i < 38; ++i) g[i] = bf2f(glu[(tb + i) * 256 + c]);
    float yv[8];
#pragma unroll
    for (int j = 0; j < 8; ++j) {
      float a = cb;
#pragma unroll
      for (int k = 0; k < 31; ++k) a += w[k] * g[j + k];
      yv[j] = a;
    }
#pragma unroll
    for (int j = 0; j < 8; ++j) {
      const float s1 = wave_sum(yv[j]);
      const float s2 = wave_sum(yv[j] * yv[j]);
      if (lane == 0) { part[((par * 8 + j) * 4 + wid) * 2 + 0] = s1; part[((par * 8 + j) * 4 + wid) * 2 + 1] = s2; }
    }
    __syncthreads();
#pragma unroll
    for (int j = 0; j < 8; ++j) {
      float s1 = 0.f, s2 = 0.f;
#pragma unroll
      for (int w2 = 0; w2 < 4; ++w2) { s1 += part[((par * 8 + j) * 4 + w2) * 2 + 0]; s2 += part[((par * 8 + j) * 4 + w2) * 2 + 1]; }
      const float mu = s1 * (1.f / 256.f);
      const float var = fmaxf(s2 * (1.f / 256.f) - mu * mu, 0.f);
      const float rs = rsqrtf(var + 1e-5f);
      const float z = (yv[j] - mu) * rs * lg + lb;
      p->convA[(size_t)(rb + t0 + tb + j) * 256 + c] = f2bf(silu_f(z));
    }
  }
}

__device__ void phaseC(KP p, int l, char* smem) {
  const int n_conv = 288, n_rows = 288;
  const int n_w = (l < 3) ? NW_ITEMS : 0;
  for (int it = blockIdx.x; it < n_conv + n_rows + n_w; it += gridDim.x) {
    if (it < n_conv) phaseC_conv(p, l, it, smem);
    else if (it < n_conv + n_rows) phaseC_rows(p, l, it - n_conv, smem);
    else wconv_item(p, l + 1, it - n_conv - n_rows, smem);
  }
}

__device__ void attn_item(KP p, int item, char* smem) {
  const int tid = tid_opaque(), lane = tid & 63, wid = tid >> 6, l15 = lane & 15, g4 = lane >> 4;
  bf16_t* sK = (bf16_t*)smem;
  bf16_t* sV = sK + 2 * 64 * KSTR;
  int b, h, qb, key0, nkeys, rowbase;
  const bf16_t* Qp;
  bool latent;
  if (item < 512) {
    b = item >> 6; h = (item >> 4) & 3; qb = item & 15; key0 = 0; nkeys = 2304; latent = true;
    Qp = p->q + ((size_t)(b * 4 + h) * 2048 + qb * 128) * 96; rowbase = b * 2048 + qb * 128;
  } else {
    const int i2 = item - 512;
    b = i2 >> 3; h = (i2 >> 1) & 3; qb = i2 & 1; key0 = 2048; nkeys = 256; latent = false;
    Qp = p->qc + ((size_t)(b * 4 + h) * 256 + qb * 128) * 96; rowbase = NLAT + b * 256 + qb * 128;
  }
  const bf16_t* Kp = p->kall + ((size_t)(b * 4 + h) * 2304 + key0) * 96;
  const bf16_t* Vp = p->vT + (size_t)(b * 4 + h) * 64 * 2304 + key0;

  u32x4 rk[3], rv[2];
  int koff[3], klds[3], voff[2], vlds[2];
#pragma unroll
  for (int i = 0; i < 3; ++i) {
    const int c = tid + 256 * i;
    const int krow = c / 12, cc = c % 12;
    koff[i] = krow * 96 + cc * 8;
    const int hh = krow >> 5, a = (krow >> 3) & 3, t = (krow >> 2) & 1, bb = krow & 3;
    klds[i] = (hh * 32 + t * 16 + a * 4 + bb) * KSTR + cc * 8;
  }
#pragma unroll
  for (int i = 0; i < 2; ++i) {
    const int c = tid + 256 * i;
    const int vrow = c >> 3, cc = c & 7;
    voff[i] = vrow * 2304 + cc * 8;
    vlds[i] = vrow * LSTR + cc * 8;
  }
  const int nt = nkeys >> 6;
#pragma unroll
  for (int i = 0; i < 3; ++i) rk[i] = *(const u32x4*)(Kp + koff[i]);
#pragma unroll
  for (int i = 0; i < 2; ++i) rv[i] = *(const u32x4*)(Vp + voff[i]);
  bf16x8 qf[2][3];
#pragma unroll
  for (int qt = 0; qt < 2; ++qt)
#pragma unroll
    for (int d = 0; d < 3; ++d)
      qf[qt][d] = *(const bf16x8*)(Qp + (size_t)(wid * 32 + qt * 16 + l15) * 96 + d * 32 + g4 * 8);
  if (latent) {
#pragma unroll
    for (int qt = 0; qt < 2; ++qt) {
      const int s = qb * 128 + wid * 32 + qt * 16 + l15;
      const float pos = (float)((g4 < 2) ? (s >> 6) : (s & 63));
      bf16x8 o = qf[qt][2];
      bf16x8 r;
#pragma unroll
      for (int j = 0; j < 8; ++j) {
        const float own = bf2f((bf16_t)o[j]);
        const float par = __shfl_xor(own, 16);
        float sn, cs;
        sincosf(pos * rope_inv(j), &sn, &cs);
        const float ov = (g4 & 1) ? (par * sn + own * cs) : (own * cs - par * sn);
        r[j] = (short)f2bf(ov);
      }
      qf[qt][2] = r;
    }
  }

  __syncthreads();
#pragma unroll
  for (int i = 0; i < 3; ++i) *(u32x4*)(sK + klds[i]) = rk[i];
#pragma unroll
  for (int i = 0; i < 2; ++i) *(u32x4*)(sV + vlds[i]) = rv[i];
  __syncthreads();

  float mrun[2] = {-1e30f, -1e30f}, lsum[2] = {0.f, 0.f};
  f32x4 O[2][4];
#pragma unroll
  for (int qt = 0; qt < 2; ++qt)
#pragma unroll
    for (int dv = 0; dv < 4; ++dv) O[qt][dv] = f32x4{0.f, 0.f, 0.f, 0.f};

  for (int it = 0; it < nt; ++it) {
    const int cur = it & 1;
    if (it + 1 < nt) {
      const bf16_t* Kn = Kp + (size_t)(it + 1) * 64 * 96;
      const bf16_t* Vn = Vp + (it + 1) * 64;
#pragma unroll
      for (int i = 0; i < 3; ++i) rk[i] = *(const u32x4*)(Kn + koff[i]);
#pragma unroll
      for (int i = 0; i < 2; ++i) rv[i] = *(const u32x4*)(Vn + voff[i]);
    }
    const bf16_t* cK = sK + cur * 64 * KSTR;
    const bf16_t* cV = sV + cur * 64 * LSTR;
    f32x4 s[2][4];
#pragma unroll
    for (int qt = 0; qt < 2; ++qt) {
#pragma unroll
      for (int k4 = 0; k4 < 4; ++k4) s[qt][k4] = f32x4{0.f, 0.f, 0.f, 0.f};
#pragma unroll
      for (int k4 = 0; k4 < 4; ++k4)
#pragma unroll
        for (int d = 0; d < 3; ++d) {
          const bf16x8 kf = *(const bf16x8*)(cK + (k4 * 16 + l15) * KSTR + d * 32 + g4 * 8);
          s[qt][k4] = __builtin_amdgcn_mfma_f32_16x16x32_bf16(kf, qf[qt][d], s[qt][k4], 0, 0, 0);
        }
    }
#pragma unroll
    for (int qt = 0; qt < 2; ++qt) {
      float mx = s[qt][0][0];
#pragma unroll
      for (int k4 = 0; k4 < 4; ++k4)
#pragma unroll
        for (int j = 0; j < 4; ++j) mx = fmaxf(mx, s[qt][k4][j]);
      mx = quad16_max(mx);
      const float mnew = fmaxf(mrun[qt], mx);
      const float alpha = __builtin_amdgcn_exp2f(mrun[qt] - mnew);
      mrun[qt] = mnew;
      float ps = 0.f;
#pragma unroll
      for (int k4 = 0; k4 < 4; ++k4)
#pragma unroll
        for (int j = 0; j < 4; ++j) {
          const float pv = __builtin_amdgcn_exp2f(s[qt][k4][j] - mnew);
          s[qt][k4][j] = pv;
          ps += pv;
        }
      lsum[qt] = lsum[qt] * alpha + ps;
#pragma unroll
      for (int dv = 0; dv < 4; ++dv) O[qt][dv] *= alpha;
      bf16x8 pf[2];
#pragma unroll
      for (int hh = 0; hh < 2; ++hh) {
        u32x4 t;
        t[0] = pack2(s[qt][hh * 2][0], s[qt][hh * 2][1]);
        t[1] = pack2(s[qt][hh * 2][2], s[qt][hh * 2][3]);
        t[2] = pack2(s[qt][hh * 2 + 1][0], s[qt][hh * 2 + 1][1]);
        t[3] = pack2(s[qt][hh * 2 + 1][2], s[qt][hh * 2 + 1][3]);
        pf[hh] = __builtin_bit_cast(bf16x8, t);
      }
#pragma unroll
      for (int dv = 0; dv < 4; ++dv)
#pragma unroll
        for (int hh = 0; hh < 2; ++hh) {
          const bf16x8 vf = *(const bf16x8*)(cV + (dv * 16 + l15) * LSTR + hh * 32 + g4 * 8);
          O[qt][dv] = __builtin_amdgcn_mfma_f32_16x16x32_bf16(vf, pf[hh], O[qt][dv], 0, 0, 0);
        }
    }
    if (it + 1 < nt) {
      bf16_t* nK = sK + (cur ^ 1) * 64 * KSTR;
      bf16_t* nV = sV + (cur ^ 1) * 64 * LSTR;
#pragma unroll
      for (int i = 0; i < 3; ++i) *(u32x4*)(nK + klds[i]) = rk[i];
#pragma unroll
      for (int i = 0; i < 2; ++i) *(u32x4*)(nV + vlds[i]) = rv[i];
    }
    __syncthreads();
  }
#pragma unroll
  for (int qt = 0; qt < 2; ++qt) {
    float lt = lsum[qt];
    lt = quad16_sum(lt);
    const float inv = 1.f / lt;
    const int row = rowbase + wid * 32 + qt * 16 + l15;
#pragma unroll
    for (int dv = 0; dv < 4; ++dv) {
      const int col = h * 64 + dv * 16 + g4 * 4;
      const uint2 gu = *(const uint2*)(p->hp + (size_t)row * HPS + HGATE + col);
      const float g0 = bf2f(gu.x & 0xffff), g1 = bf2f(gu.x >> 16), g2 = bf2f(gu.y & 0xffff), g3 = bf2f(gu.y >> 16);
      uint2 u;
      u.x = pack2(O[qt][dv][0] * inv * silu_f(g0), O[qt][dv][1] * inv * silu_f(g1));
      u.y = pack2(O[qt][dv][2] * inv * silu_f(g2), O[qt][dv][3] * inv * silu_f(g3));
      *(uint2*)(p->y + (size_t)row * 1024 + col) = u;
    }
  }
}

__device__ void phaseZ(KP p) {
  const int tid = tid_opaque(), lane = tid & 63, wid = tid >> 6;
  for (int it = blockIdx.x; it < NLAT / 4; it += gridDim.x) {
    const int row = it * 4 + wid;
    float* xr = p->out + (size_t)row * 1024;
    float4 v[4];
    float ss = 0.f;
#pragma unroll
    for (int e = 0; e < 4; ++e) {
      v[e] = *(const float4*)(xr + e * 256 + lane * 4);
      ss += v[e].x * v[e].x + v[e].y * v[e].y + v[e].z * v[e].z + v[e].w * v[e].w;
    }
    ss = wave_sum(ss);
    const float rstd = rsqrtf(ss * (1.f / 1024.f) + 1e-6f);
#pragma unroll
    for (int e = 0; e < 4; ++e) {
      const float4 g = *(const float4*)(p->final_g + e * 256 + lane * 4);
      float4 o;
      o.x = v[e].x * rstd * g.x; o.y = v[e].y * rstd * g.y; o.z = v[e].z * rstd * g.z; o.w = v[e].w * rstd * g.w;
      *(float4*)(xr + e * 256 + lane * 4) = o;
    }
  }
}


__device__ void dft_nyquist_item(KP p, int b, int part) {
  const int tid = tid_opaque();
  const int c = part * 64 + (tid >> 2), sub = tid & 3;
  const bf16_t* xr = p->XT + ((size_t)b * 256 + c) * 2048 + sub * 512;
  float acc = 0.f;
#pragma unroll 8
  for (int i = 0; i < 64; ++i) {
    const u32x4 u = *(const u32x4*)(xr + i * 8);
#pragma unroll
    for (int e2 = 0; e2 < 4; ++e2) acc += bf2f((bf16_t)(u[e2] & 0xffff)) - bf2f((bf16_t)(u[e2] >> 16));
  }
  acc += __shfl_xor(acc, 1);
  acc += __shfl_xor(acc, 2);
  if (sub == 0) {
    bf16_t* t = p->T + (size_t)(b * 2048 + 1024) * 512;
    t[c] = f2bf(acc * 0.02209708691207961f);
    t[256 + c] = 0;
  }
}

#define XB_TMO      128
#define XB_XCNT(j)  (256  + 64 * (j))
#define XB_XSUB(j)  (1280 + 64 * (j))
#define XB_XGEN(j)  (2304 + 64 * (j))
#define XB_TOP      3328
#define XB_TOPGEN   3392
#define XCD_BAR_WORDS 3456
#define XB_SPIN_CAP (1u << 20)
#define LAS __attribute__((address_space(3)))
__device__ __forceinline__ unsigned xb_ld(unsigned* p) { return __hip_atomic_load(p, __ATOMIC_RELAXED, __HIP_MEMORY_SCOPE_AGENT); }
__device__ __forceinline__ unsigned xb_add(unsigned* p, unsigned v) { return __hip_atomic_fetch_add(p, v, __ATOMIC_RELAXED, __HIP_MEMORY_SCOPE_AGENT); }
__device__ __forceinline__ unsigned xb_xcc_id() { return (unsigned)__builtin_amdgcn_s_getreg((3 << 11) | 20) & 0xFu; }
#define XB_SPIN(cond, bar) do { unsigned _sp = 0; while (cond) { __builtin_amdgcn_s_sleep(1); \
    if ((++_sp & 255u) == 0u) { if (xb_ld(&(bar)[XB_TMO])) break; if (_sp > XB_SPIN_CAP) { atomicAdd(&(bar)[XB_TMO], 1u); break; } } } } while (0)
struct XcdBarrier { unsigned* bar; unsigned x; volatile LAS unsigned* st; };
__device__ __forceinline__ XcdBarrier xcd_barrier_post(unsigned* bar, volatile LAS unsigned* st) {
  XcdBarrier b; b.bar = bar; b.x = xb_xcc_id(); b.st = st;
  if (threadIdx.x == 0) (void)xb_add(&bar[XB_XCNT(b.x)], 1u);
  return b;
}
__device__ __forceinline__ void xcd_barrier_complete(unsigned* bar, unsigned x, unsigned& nloc, unsigned& nx) {
  const unsigned G = gridDim.x * gridDim.y * gridDim.z;
  unsigned sum, cnt, mine, sp = 0u;
  for (;;) {
    sum = 0u; cnt = 0u; mine = 0u;
#pragma unroll
    for (unsigned j = 0; j < 16; ++j) { const unsigned c = xb_ld(&bar[XB_XCNT(j)]); sum += c; cnt += (c > 0u) ? 1u : 0u; mine = (j == x) ? c : mine; }
    if (sum == G) break;
    __builtin_amdgcn_s_sleep(1);
    if ((++sp & 255u) == 0u) { if (xb_ld(&bar[XB_TMO])) break; if (sp > XB_SPIN_CAP) { atomicAdd(&bar[XB_TMO], 1u); break; } }
  }
  nloc = mine > 0u ? mine : 1u; nx = cnt > 0u ? cnt : 1u;
}
__device__ __forceinline__ void xcd_barrier(const XcdBarrier& b) {
  asm volatile("s_waitcnt vmcnt(0)" ::: "memory");
  __syncthreads();
  if (threadIdx.x == 0) {
    unsigned* bar = b.bar;
    __builtin_amdgcn_s_waitcnt(0);
    unsigned nloc = b.st[0], nx = b.st[1];
    if (nloc == 0u) { xcd_barrier_complete(bar, b.x, nloc, nx); b.st[0] = nloc; b.st[1] = nx; }
    const unsigned old = xb_add(&bar[XB_XSUB(b.x)], 1u);
    const unsigned gen = old / nloc;
    if (old + 1u == (gen + 1u) * nloc) {
      __builtin_amdgcn_fence(__ATOMIC_RELEASE, "agent");
      asm volatile("s_waitcnt vmcnt(0)" ::: "memory");
      const unsigned og = xb_add(&bar[XB_TOP], 1u);
      const unsigned tg = og / nx;
      if (og + 1u == (tg + 1u) * nx) xb_add(&bar[XB_TOPGEN], 1u);
      else XB_SPIN(xb_ld(&bar[XB_TOPGEN]) == tg, bar);
      __builtin_amdgcn_fence(__ATOMIC_ACQUIRE, "agent");
      xb_add(&bar[XB_XGEN(b.x)], 1u);
      asm volatile("s_waitcnt vmcnt(0)" ::: "memory");
    } else {
      XB_SPIN(xb_ld(&bar[XB_XGEN(b.x)]) == gen, bar);
      __builtin_amdgcn_fence(__ATOMIC_ACQUIRE, "agent");
      asm volatile("s_waitcnt vmcnt(0)" ::: "memory");
    }
  }
  __syncthreads();
}

constexpr int N_PHASES = 26;
constexpr int SMEM_BYTES = 49152;

__device__ __forceinline__ int gemm_phase_items(int l, int s) {
  if (s == 1) return 144 * 22;
  if (s == 3) return 512 + 432 + 576 + 288 + 576 + 64;
  if (s == 4) return ((l == 3) ? 512 : 576) + 288;
  return (l == 3 ? 128 : 144) * 8;
}

template <bool COOP>
__global__ void __launch_bounds__(256, 2) mega(Params p_unused, int ph_lo, int ph_hi) {
  __shared__ __attribute__((aligned(16))) char smem[SMEM_BYTES];
  __shared__ uint4 xb_words;
  if (threadIdx.x == 0) xb_words = make_uint4(0u, 0u, 0u, 0u);
  __syncthreads();
  if (ph_lo < 0) cg::this_grid().sync();
  XcdBarrier xb = xcd_barrier_post(kparams()->bar, (volatile LAS unsigned*)&xb_words);
#ifndef PROBE_S
#define PROBE_S -1
#endif
#ifndef PROBE_SYNCS
#define PROBE_SYNCS 0
#endif
  for (int ph2 = ph_lo * 2; ph2 < ph_hi * 2; ++ph2) {
    const int ph = ph2 >> 1;
    if (ph2 & 1) {
      const bool rep = (PROBE_S == 6) ? (ph == 0) : ((PROBE_S >= 0) && ph != 0 && ph != N_PHASES - 1 && ((ph - 1) % 6) == PROBE_S);
      if (COOP && (rep || ph + 1 < ph_hi)) xcd_barrier(xb);
      if (!rep) continue;
    }
    KP p = kparams();
    if (ph == 0) phase0(p, smem);
    else if (ph == N_PHASES - 1) phaseZ(p);
    else {
      const int l = (ph - 1) / 6, s = (ph - 1) % 6;
      if (s == 0) phaseA(p, l, smem);
      else {
        const int xcd = blockIdx.x & 7, lrank = blockIdx.x >> 3, nl = gridDim.x >> 3;
        int nloc;
        if (s == 1) nloc = 396;
        else if (s == 2) nloc = 116 + ((l < 3) ? NW_ITEMS / 8 : 0);
        else if (s == 3) nloc = 270;
        else if (s == 4) nloc = (l == 3) ? 64 : 72;
        else nloc = (l == 3) ? 128 : 144;
        unsigned* qctr = kparams()->bar + XCD_BAR_WORDS + (ph2 * 8 + xcd) * 16;
        (void)lrank; (void)nl;
        for (;;) {
          __syncthreads();
          if (threadIdx.x == 0) xb_words.w = __hip_atomic_fetch_add(qctr, 1u, __ATOMIC_RELAXED, __HIP_MEMORY_SCOPE_AGENT);
          __syncthreads();
          const int q0 = (int)((volatile uint4*)&xb_words)->w;
          if (q0 >= nloc) break;
          KP p = kparams();
          const bf16_t *A, *Bt;
          int lda, ldb, K, m0, n0, nt4 = 1, isattn = 0, it = 0;
          EpiAny e{};
          e.l = l;
          int q = q0;
          if (s == 1) {
            const int mtl = (q / 132) * 6 + q % 6, nt = (q / 6) % 22;
            A = p->h; lda = 1024; Bt = p->WinT; ldb = 1024; K = 1024; m0 = (xcd * 18 + mtl) * 128; n0 = nt * 128; e.kind = EK_IN;
          } else if (s == 2) {
            if (q < 32) {
              const int b = xcd;
              A = p->XT + (size_t)b * 256 * 2048; lda = 2048; Bt = p->CS2048; ldb = 2048; K = 2048;
              m0 = (q & 1) * 128; n0 = (q >> 1) * 128; e.kind = EK_DFT; e.i0 = b * 2048; e.i1 = 1023; e.i2 = 10; e.i3 = 1;
            } else if (q < 68) { phaseC_conv(p, l, xcd * 36 + (q - 32), smem); continue; }
            else if (q < 104) { phaseC_rows(p, l, xcd * 36 + (q - 68), smem); continue; }
            else if (q < 112) {
              q -= 104;
              const int b = xcd;
              A = p->XTc + (size_t)b * 256 * 256; lda = 256; Bt = p->CS256; ldb = 256; K = 256;
              m0 = (q & 1) * 128; n0 = ((q >> 1) & 3) * 128; e.kind = EK_DFT; e.i0 = NLAT + b * 256; e.i1 = 255; e.i2 = 8; e.i3 = 0;
            } else if (q < 116) { dft_nyquist_item(p, xcd, q - 112); continue; }
            else { wconv_item(p, l + 1, xcd * (NW_ITEMS / 8) + (q - 116), smem); continue; }
          } else if (s == 3) {
            if (q < 54) {
              A = p->hp + HQ; lda = HPS; Bt = p->WuqT + (size_t)(l & 1) * 384 * 256; ldb = 256; K = 256;
              m0 = (xcd * 18 + q / 3) * 128; n0 = (q % 3) * 128; e.kind = EK_Q;
            } else if ((q -= 54) < 72) {
              A = p->hp + HKV; lda = HPS; Bt = p->WukvT + (size_t)(l & 1) * 512 * 128; ldb = 128; K = 128;
              m0 = (xcd * 18 + (q >> 2)) * 128; n0 = (q & 3) * 128; e.kind = EK_KV;
            } else if ((q -= 72) < 36) {
              A = p->convA; lda = 256; Bt = p->WpwT + (size_t)(l & 1) * 65536; ldb = 256; K = 256;
              m0 = (xcd * 18 + (q >> 1)) * 128; n0 = (q & 1) * 128;
              e.kind = EK_GATED; e.f0 = p->b_pw + l * 256; e.i0 = HGATE + 256; e.i1 = 256;
            } else if ((q -= 36) < 72) {
              const int chunk = xcd * 18 + (q >> 2), g = q & 3;
              A = p->Wsb + (size_t)(l & 1) * 65536 + (size_t)g * 16384; lda = 128;
              Bt = p->vnT + ((size_t)chunk * 256 + g * 64) * 128; ldb = 128; K = 128;
              m0 = 0; n0 = 0; nt4 = 0; e.kind = EK_SGU; e.f0 = p->b_s + (size_t)(l * 4 + g) * 128; e.i0 = chunk * 128; e.i1 = g;
            } else {
              q -= 72;
              A = p->T; lda = 512; Bt = p->WfT + (size_t)(l & 1) * 256 * 512; ldb = 512; K = 512;
              m0 = (xcd * 18 + (q >> 1)) * 128; n0 = (q & 1) * 128;
              e.kind = EK_GATED; e.f0 = p->b_fourier + l * 256; e.i0 = HGATE + 512; e.i1 = 512;
            }
          } else if (s == 4) {
            isattn = 1; A = nullptr; Bt = nullptr; lda = ldb = K = m0 = n0 = 0;
            it = (q < 64) ? (xcd * 64 + q) : (512 + xcd * 8 + (q - 64));
          } else {
            int mt, nt;
            if (l == 3) { mt = xcd * 16 + (q / 64) * 8 + (q & 7); nt = (q >> 3) & 7; }
            else { mt = xcd * 18 + (q / 72) * 9 + q % 9; nt = (q / 9) & 7; }
            A = p->y; lda = 1024; Bt = p->WoutT + (size_t)(l & 1) * 1024 * 1024; ldb = 1024; K = 1024;
            m0 = mt * 128; n0 = nt * 128; e.kind = EK_OUT;
          }
          if (isattn) attn_item(p, it, smem);
          else if (nt4) gemm_bd(A, lda, Bt, K, m0, n0, p, e, (bf16_t*)smem);
          else gemm_tile<2>(A, lda, Bt, ldb, K, m0, n0, p, e, (bf16_t*)smem);
        }
      }
    }
    if (COOP) {
      if ((ph2 & 1) && ph + 1 < ph_hi) xcd_barrier(xb);
      if (!(ph2 & 1)) for (int k = 0; k < PROBE_SYNCS; ++k) xcd_barrier(xb);
    }
  }
}


extern "C" void kernel_launch(void* const* d_in, const int* in_sizes, int n_in, void* d_out, int out_size, void* d_ws,
                              size_t ws_size, hipStream_t stream) {
  Params p{};
  const float** pp = (const float**)&p;
  for (int i = 0; i < 26; ++i) pp[i] = (const float*)d_in[i];
  p.out = (float*)d_out;
  char* w = (char*)d_ws;
  size_t off = 0;
  auto take = [&](size_t bytes) { char* r = w + off; off += (bytes + 255) & ~(size_t)255; return r; };
  p.xc = (float*)take((size_t)2048 * 1024 * 4);
  p.mod = (float*)take((size_t)4 * 9 * 3072 * 4);
  p.rstdq = (float*)take((size_t)NROW * 4);
  p.rstdkv = (float*)take((size_t)NROW * 4);
  p.h = (bf16_t*)take((size_t)NROW * 1024 * 2);
  p.convA = p.h;
  p.vnT = p.h + (size_t)NROW * 256;
  p.T = p.h + (size_t)NROW * 512;
  p.y = (bf16_t*)take((size_t)NROW * 1024 * 2);
  p.hp = (bf16_t*)take((size_t)NROW * HPS * 2);
  p.XT = (bf16_t*)take((size_t)8 * 256 * 2048 * 2);
  p.XTc = (bf16_t*)take((size_t)8 * 256 * 256 * 2);
  p.q = (bf16_t*)take((size_t)8 * 4 * 2048 * 96 * 2);
  p.qc = (bf16_t*)take((size_t)8 * 4 * 256 * 96 * 2);
  p.kall = (bf16_t*)take((size_t)8 * 4 * 2304 * 96 * 2);
  p.vT = (bf16_t*)take((size_t)8 * 4 * 64 * 2304 * 2);
  p.WinT = (bf16_t*)take((size_t)NIN * 1024 * 2);
  p.WoutT = (bf16_t*)take((size_t)2 * 1024 * 1024 * 2);
  p.WuqT = (bf16_t*)take((size_t)2 * 384 * 256 * 2);
  p.WukvT = (bf16_t*)take((size_t)2 * 512 * 128 * 2);
  p.WpwT = (bf16_t*)take((size_t)2 * 256 * 256 * 2);
  p.WfT = (bf16_t*)take((size_t)2 * 256 * 512 * 2);
  p.Wsb = (bf16_t*)take((size_t)2 * 4 * 128 * 128 * 2);
  p.CS2048 = (bf16_t*)take((size_t)2048 * 2048 * 2);
  p.CS256 = (bf16_t*)take((size_t)512 * 256 * 2);
  p.bar = (unsigned*)take((size_t)(XCD_BAR_WORDS + 2 * N_PHASES * 8 * 16) * 4);
  if (off > ws_size) { fprintf(stderr, "kernel_launch: workspace too small: need %zu have %zu\n", off, ws_size); return; }

#if MK_COOP
  static int grid_blocks = 0;
  if (!grid_blocks) {
    int dev = 0, cus = 0, per_cu = 0;
    hipGetDevice(&dev);
    hipDeviceGetAttribute(&cus, hipDeviceAttributeMultiprocessorCount, dev);
    hipOccupancyMaxActiveBlocksPerMultiprocessor(&per_cu, mega<true>, 256, 0);
    if (per_cu > 2) per_cu = 2;
    if (per_cu < 1) per_cu = 1;
    grid_blocks = cus * per_cu;
  }
  hipMemsetAsync(p.bar, 0, (size_t)(XCD_BAR_WORDS + 2 * N_PHASES * 8 * 16) * 4, stream);
  int lo = 0, hi = N_PHASES;
  void* args[] = {&p, &lo, &hi};
  hipError_t e = hipLaunchCooperativeKernel((void*)mega<true>, dim3(grid_blocks), dim3(256), args, 0, stream);
  if (e != hipSuccess) fprintf(stderr, "cooperative launch failed: %s (grid %d)\n", hipGetErrorString(e), grid_blocks);
#else
  for (int ph = 0; ph < N_PHASES; ++ph) hipLaunchKernelGGL(mega<false>, dim3(512), dim3(256), 0, stream, p, ph, ph + 1);
#endif
}
```
